# Optimizing an MI355X kernel written in HIP

```python
import math
import jax, jax.numpy as jnp
from jax import lax
import numpy as np

D_MODEL = 1024
BATCH = 1
SEQ = 16384
DEPTH = 4

EPS = 1e-6
D_FF = -(-8 * D_MODEL // (3 * 256)) * 256

POOL_WINDOWS = (2, 4, 8, 16)
POOL_WIDTH = D_MODEL // 2
POOL_GROUP = POOL_WIDTH // len(POOL_WINDOWS)

HGRN_HEADS = 4
HGRN_DK = 128
HGRN_DV = (D_MODEL // 2) // HGRN_HEADS
HGRN_CHUNK = 64
HGRN_KW = HGRN_HEADS * HGRN_DK
HGRN_VW = HGRN_HEADS * HGRN_DV

HYB_IN = POOL_WIDTH + 2 * HGRN_KW + 2 * HGRN_VW
HYB_OUT = POOL_WIDTH + HGRN_VW

DIL_GROUPS = ((128, 1), (512, 4), (2048, 16))
ATT_HEADS_PER_GROUP = 8
ATT_HEAD_DIM = 64
ATT_GROUP_WIDTH = ATT_HEADS_PER_GROUP * ATT_HEAD_DIM
N_ATT_HEADS = len(DIL_GROUPS) * ATT_HEADS_PER_GROUP
ATT_QKV = 3 * len(DIL_GROUPS) * ATT_GROUP_WIDTH
ATT_OUT = ATT_GROUP_WIDTH
REL_BUCKETS = 32
REL_MAX_DIST = 2048

N_HYB = (DEPTH + 1) // 2
N_ATT = DEPTH // 2

kernel_name = 'hybrid_pool_hgrn2_dilated_attn_trunk'


def rms_norm(x, gain):
    xf = x.astype(jnp.float32)
    y = xf * lax.rsqrt(jnp.mean(xf * xf, axis=-1, keepdims=True) + EPS)
    return (y * gain.astype(jnp.float32)).astype(x.dtype)


def t5_bucket(dist):
    max_exact = REL_BUCKETS // 2
    df = jnp.maximum(dist, 1).astype(jnp.float32)
    large = max_exact + (jnp.log(df / max_exact) / math.log(REL_MAX_DIST / max_exact)
                         * (REL_BUCKETS - max_exact)).astype(jnp.int32)
    large = jnp.minimum(large, REL_BUCKETS - 1)
    return jnp.where(dist < max_exact, dist, large)


def pool_mixer(u, w, scale):
    B, S, _ = u.shape
    uf = u.astype(jnp.float32)
    wmax = max(POOL_WINDOWS)
    cs = jnp.cumsum(uf, axis=1)
    cs_pad = jnp.pad(cs, ((0, 0), (wmax, 0), (0, 0)))
    pos = jnp.arange(S)
    diffs = []
    for gi, win in enumerate(POOL_WINDOWS):
        sl = slice(gi * POOL_GROUP, (gi + 1) * POOL_GROUP)
        window_sum = cs[:, :, sl] - cs_pad[:, wmax - win: wmax - win + S, sl]
        count = jnp.minimum(pos + 1, win).astype(jnp.float32)[None, :, None]
        diffs.append(window_sum / count - uf[:, :, sl])
    d = jnp.stack(diffs, axis=2)
    y = jnp.einsum('bsgc,gcd->bsgd', d, w.astype(jnp.float32)).reshape(B, S, POOL_WIDTH)
    return (y * scale.astype(jnp.float32)).astype(u.dtype)


def hgrn2_mixer(q_raw, f_raw, v_raw, g_raw, lb, out_gain):
    B, S, _ = q_raw.shape
    H, K, V, C = HGRN_HEADS, HGRN_DK, HGRN_DV, HGRN_CHUNK
    n = S // C
    q = jax.nn.silu(q_raw.astype(jnp.float32)).reshape(B, S, H, K)
    z = f_raw.astype(jnp.float32).reshape(B, S, H, K)
    lb = lb.astype(jnp.float32).reshape(H, K)
    log_f = jnp.logaddexp(jnp.log(lb), jnp.log1p(-lb) + jax.nn.log_sigmoid(z))
    k = (1.0 - lb) * jax.nn.sigmoid(-z)
    v = v_raw.astype(jnp.float32).reshape(B, S, H, V)

    def chunks(t):
        return t.reshape(B, n, C, H, t.shape[-1]).transpose(1, 0, 3, 2, 4)

    qc, kc, vc, lfc = chunks(q), chunks(k), chunks(v), chunks(log_f)
    bc = jnp.cumsum(lfc, axis=3)
    causal = jnp.tril(jnp.ones((C, C), dtype=bool))

    def step(state, inp):
        qt, kt, vt, bt = inp
        b_last = bt[:, :, -1:, :]
        o_inter = jnp.einsum('bhtk,bhkv->bhtv', qt * jnp.exp(bt), state)
        rel = jnp.where(causal[:, :, None], bt[:, :, :, None, :] - bt[:, :, None, :, :], -jnp.inf)
        a = jnp.einsum('bhtsk,bhsk->bhts', qt[:, :, :, None, :] * jnp.exp(rel), kt)
        o_intra = jnp.einsum('bhts,bhsv->bhtv', a, vt)
        k_dec = kt * jnp.exp(b_last - bt)
        state = (jnp.exp(b_last[:, :, 0, :, None]) * state
                 + jnp.einsum('bhsk,bhsv->bhkv', k_dec, vt))
        return state, o_inter + o_intra

    state0 = jnp.zeros((B, H, K, V), jnp.float32)
    _, o = lax.scan(step, state0, (qc, kc, vc, bc))
    o = o.transpose(1, 0, 3, 2, 4).reshape(B, S, H, V)
    o = rms_norm(o, out_gain) * jax.nn.silu(g_raw.astype(jnp.float32).reshape(B, S, H, V))
    return o.reshape(B, S, HGRN_VW).astype(q_raw.dtype)


def _to_strided(t, dil, blk):
    B, S, H, E = t.shape
    L = S // dil
    nb = -(-L // blk)
    t = t.reshape(B, L, dil, H, E).transpose(0, 2, 1, 3, 4)
    t = jnp.pad(t, ((0, 0), (0, 0), (0, nb * blk - L), (0, 0), (0, 0)))
    return t.reshape(B, dil, nb, blk, H, E)


def _from_strided(t, S):
    B, dil, nb, blk = t.shape[:4]
    tail = t.shape[4:]
    L = S // dil
    t = t.reshape(B, dil, nb * blk, *tail)[:, :, :L]
    return jnp.moveaxis(t, 1, 2).reshape(B, S, *tail)


def dilated_group_attention(q, k, v, win, dil, bias_table):
    S = q.shape[1]
    blk = win // dil
    qs = _to_strided(q * ATT_HEAD_DIM ** -0.5, dil, blk)
    ks = _to_strided(k, dil, blk)
    vs = _to_strided(v, dil, blk)
    nb = qs.shape[2]

    def with_prev(t):
        prev = jnp.pad(t[:, :, :-1], ((0, 0), (0, 0), (1, 0), (0, 0), (0, 0), (0, 0)))
        return jnp.concatenate([prev, t], axis=3)

    kk, vv = with_prev(ks), with_prev(vs)
    qi = jnp.arange(blk)[:, None]
    ki = jnp.arange(2 * blk)[None, :]
    dist = blk + qi - ki
    band = (dist >= 0) & (dist <= blk)
    bias = bias_table[t5_bucket(jnp.maximum(dist, 0) * dil)].astype(jnp.float32).transpose(2, 0, 1)
    has_prev = (jnp.arange(nb) > 0)[:, None, None] | (ki >= blk)[None]
    mask = band[None] & has_prev
    s = jnp.einsum('brnqhe,brnkhe->brnhqk', qs, kk) + bias
    s = jnp.where(mask[None, None, :, None], s, -jnp.inf)
    m = jnp.max(s, axis=-1, keepdims=True)
    p = jnp.exp(s - m)
    l = jnp.sum(p, axis=-1, keepdims=True)
    mt = jnp.moveaxis(m, 3, 4)
    lt = jnp.moveaxis(l, 3, 4)
    o = jnp.einsum('brnhqk,brnkhe->brnqhe', p, vv) / lt
    return _from_strided(o, S), _from_strided(mt, S), _from_strided(lt, S)


def dilated_attention_mixer(qkv, rel_bias):
    B, S, _ = qkv.shape
    G, Hg = len(DIL_GROUPS), ATT_HEADS_PER_GROUP
    t = qkv.astype(jnp.float32).reshape(B, S, 3, G, Hg, ATT_HEAD_DIM)
    outs, maxes, dens = [], [], []
    for gi, (win, dil) in enumerate(DIL_GROUPS):
        o, m, l = dilated_group_attention(t[:, :, 0, gi], t[:, :, 1, gi], t[:, :, 2, gi], win, dil,
                                          rel_bias[:, gi * Hg:(gi + 1) * Hg])
        outs.append(o)
        maxes.append(m)
        dens.append(l)
    o_all = jnp.stack(outs)
    m_all = jnp.stack(maxes)
    l_all = jnp.stack(dens)
    w = l_all * jnp.exp(m_all - jnp.max(m_all, axis=0, keepdims=True))
    o = jnp.sum(w * o_all, axis=0) / jnp.sum(w, axis=0)
    return o.reshape(B, S, ATT_OUT).astype(qkv.dtype)


def swiglu(h, w_in, w_out):
    a, b = jnp.split(h @ w_in, 2, axis=-1)
    return (jax.nn.silu(a) * b) @ w_out


def modulation(c, w, b):
    return jnp.split(jax.nn.silu(c) @ w + b, 3, axis=-1)


def sandwich(x, mod, g_pre, g_post, fn):
    shift, scale, gate = mod
    h = rms_norm(x, g_pre) * (1.0 + scale[:, None]) + shift[:, None]
    return x + gate[:, None] * rms_norm(fn(h), g_post)


def setup_inputs(seed: int = 0) -> dict:
    key = jax.random.key(seed)
    ks = jax.random.split(key, 17)

    def nrm(k, shape, scale):
        return jax.random.normal(k, shape, jnp.float32) * scale

    D = D_MODEL
    return {
        'x': nrm(ks[0], (BATCH, SEQ, D), 1.0),
        'c': nrm(ks[1], (BATCH, D), 1.0),
        'ada_w': nrm(ks[2], (DEPTH, 2, D, 3 * D), D ** -0.5),
        'ada_b': nrm(ks[3], (DEPTH, 2, 3 * D), 0.01),
        'norm_pre': 1.0 + nrm(ks[4], (DEPTH, 2, D), 0.1),
        'norm_post': 1.0 + nrm(ks[5], (DEPTH, 2, D), 0.1),
        'ffn_w_in': nrm(ks[6], (DEPTH, D, 2 * D_FF), D ** -0.5),
        'ffn_w_out': nrm(ks[7], (DEPTH, D_FF, D), D_FF ** -0.5),
        'hyb_w_in': nrm(ks[8], (N_HYB, D, HYB_IN), D ** -0.5),
        'hyb_w_out': nrm(ks[9], (N_HYB, HYB_OUT, D), HYB_OUT ** -0.5),
        'pool_w': nrm(ks[10], (N_HYB, len(POOL_WINDOWS), POOL_GROUP, POOL_GROUP), POOL_GROUP ** -0.5),
        'pool_scale': 1.0 + nrm(ks[11], (N_HYB, POOL_WIDTH), 0.1),
        'hgrn_lb_logits': nrm(ks[12], (N_HYB, HGRN_KW), 1.0),
        'hgrn_out_norm': 1.0 + nrm(ks[13], (N_HYB, HGRN_DV), 0.1),
        'att_w_qkv': nrm(ks[14], (N_ATT, D, ATT_QKV), D ** -0.5),
        'att_w_out': nrm(ks[15], (N_ATT, ATT_OUT, D), ATT_OUT ** -0.5),
        'rel_bias': nrm(ks[16], (REL_BUCKETS, N_ATT_HEADS), 0.5),
    }


def reference(x, c, ada_w, ada_b, norm_pre, norm_post, ffn_w_in, ffn_w_out, hyb_w_in, hyb_w_out,
              pool_w, pool_scale, hgrn_lb_logits, hgrn_out_norm, att_w_qkv, att_w_out, rel_bias):
    lb_cum = jnp.cumsum(jax.nn.softmax(hgrn_lb_logits.astype(jnp.float32), axis=0), axis=0)
    lower_bounds = jnp.maximum(lb_cum - lb_cum[:1], 0.0)
    split_at = [POOL_WIDTH, POOL_WIDTH + HGRN_KW, POOL_WIDTH + 2 * HGRN_KW, POOL_WIDTH + 2 * HGRN_KW + HGRN_VW]

    for layer in range(DEPTH):
        j = layer // 2
        if layer % 2 == 0:
            def mixer(h, j=j):
                u, qr, fr, vr, gr = jnp.split(h @ hyb_w_in[j], split_at, axis=-1)
                y = jnp.concatenate([pool_mixer(u, pool_w[j], pool_scale[j]),
                                     hgrn2_mixer(qr, fr, vr, gr, lower_bounds[j], hgrn_out_norm[j])], axis=-1)
                return y @ hyb_w_out[j]
        else:
            def mixer(h, j=j):
                return dilated_attention_mixer(h @ att_w_qkv[j], rel_bias) @ att_w_out[j]

        def ffn(h, l=layer):
            return swiglu(h, ffn_w_in[l], ffn_w_out[l])

        x = sandwich(x, modulation(c, ada_w[layer, 0], ada_b[layer, 0]), norm_pre[layer, 0], norm_post[layer, 0], mixer)
        x = sandwich(x, modulation(c, ada_w[layer, 1], ada_b[layer, 1]), norm_pre[layer, 1], norm_post[layer, 1], ffn)
    return x
```

```cpp
#include <hip/hip_runtime.h>
#include <cstdio>
#include <cstdint>

typedef unsigned short bf16;
__device__ __forceinline__ float bf2f(bf16 b) { return __uint_as_float(((unsigned)b) << 16); }
__device__ __forceinline__ bf16 f2bf(float f) { unsigned u = __float_as_uint(f); u += 0x7fffu + ((u >> 16) & 1u); return (bf16)(u >> 16); }
__device__ __forceinline__ float siluf(float v) { return v / (1.f + __expf(-v)); }
__device__ __forceinline__ float sigmf(float v) { return 1.f / (1.f + __expf(-v)); }

constexpr int M = 16384, D = 1024, DEPTH = 4, DFF = 2816;
constexpr int HYB_IN = 2560, ATT_QKV = 4608;
constexpr float EPS = 1e-6f;
constexpr size_t MiB = 1u << 20;
constexpr size_t WS_MOD = 1 * MiB;
constexpr size_t WS_BIAS = 1 * MiB + 256 * 1024;
constexpr size_t WS_WFI = 2 * MiB, WS_WFO = 46 * MiB, WS_WHI = 68 * MiB, WS_WHO = 78 * MiB, WS_WQKV = 82 * MiB, WS_WAO = 100 * MiB, WS_WPOOL = 102 * MiB;
constexpr size_t WS_H = 104 * MiB, WS_P = 136 * MiB, WS_YM = 280 * MiB, WS_Y = 312 * MiB, WS_ORAW = 344 * MiB, WS_END = 376 * MiB;

template <int MODE>
__global__ void k_wconv(const float* W, bf16* Bt, int K, int N, size_t wstride, size_t bstride) {
    __shared__ float t[32][33];
    W += blockIdx.z * wstride; Bt += blockIdx.z * bstride;
    const int n0 = blockIdx.x * 32, k0 = blockIdx.y * 32;
    int src_n0 = n0;
    if (MODE == 1) { const int tile = n0 / 256, r = n0 % 256; src_n0 = (r < 128) ? tile * 128 + r : DFF + tile * 128 + (r - 128); }
    for (int i = threadIdx.y; i < 32; i += 8) t[i][threadIdx.x] = W[(size_t)(k0 + i) * N + src_n0 + threadIdx.x];
    __syncthreads();
    for (int i = threadIdx.y; i < 32; i += 8) Bt[(size_t)(n0 + i) * K + k0 + threadIdx.x] = f2bf(t[threadIdx.x][i]);
}
__global__ void k_poolw(const float* W, bf16* Wt) {
    const int idx = blockIdx.x * blockDim.x + threadIdx.x;
    const int g = idx / 16384, r = idx % 16384, d = r / 128, c = r % 128;
    Wt[idx] = f2bf(W[(size_t)g * 16384 + c * 128 + d]);
}
__global__ void k_mod(const float* c, const float* ada_w, const float* ada_b, float* mod) {
    const int idx = blockIdx.x * blockDim.x + threadIdx.x;
    const int ls = idx / 3072, col = idx % 3072;
    const float* w = ada_w + (size_t)ls * 1024 * 3072;
    float acc = 0.f;
    for (int k = 0; k < 1024; ++k) acc += siluf(c[k]) * w[(size_t)k * 3072 + col];
    mod[idx] = acc + ada_b[idx];
}
__device__ __forceinline__ int t5_bucket(int d) {
    if (d < 16) return d;
    int large = 16 + (int)(logf((float)d / 16.f) / 4.852030263919617f * 16.f);
    return large < 31 ? large : 31;
}
__global__ void k_biastab(const float* rel_bias, float* tab) {
    const int idx = blockIdx.x * blockDim.x + threadIdx.x;
    if (idx >= 24 * 129) return;
    const int head = idx / 129, j = idx % 129, g = head / 8;
    const int dil = g == 0 ? 1 : (g == 1 ? 4 : 16);
    tab[idx] = rel_bias[t5_bucket(j * dil) * 24 + head];
}

__device__ __forceinline__ float wave_sum(float v) {
#pragma unroll
    for (int o = 1; o < 64; o <<= 1) v += __shfl_xor(v, o);
    return v;
}
__global__ void k_row(const float* xin, const float* Y, float* xout, bf16* H, const float* gate, const float* g_post,
                      const float* g_pre, const float* shift, const float* scale) {
    const int row = blockIdx.x * 4 + (threadIdx.x >> 6), lane = threadIdx.x & 63;
    float4 xv[4];
    const float4* xr = (const float4*)(xin + (size_t)row * D) + lane;
#pragma unroll
    for (int j = 0; j < 4; ++j) xv[j] = xr[64 * j];
    if (Y) {
        float4 yv[4]; float s = 0.f;
        const float4* yr = (const float4*)(Y + (size_t)row * D) + lane;
#pragma unroll
        for (int j = 0; j < 4; ++j) { yv[j] = yr[64 * j]; s += yv[j].x * yv[j].x + yv[j].y * yv[j].y + yv[j].z * yv[j].z + yv[j].w * yv[j].w; }
        const float rstd = rsqrtf(wave_sum(s) * (1.f / D) + EPS);
#pragma unroll
        for (int j = 0; j < 4; ++j) {
            const float4 ga = ((const float4*)gate)[lane + 64 * j], gp = ((const float4*)g_post)[lane + 64 * j];
            xv[j].x += ga.x * (yv[j].x * rstd * gp.x); xv[j].y += ga.y * (yv[j].y * rstd * gp.y);
            xv[j].z += ga.z * (yv[j].z * rstd * gp.z); xv[j].w += ga.w * (yv[j].w * rstd * gp.w);
        }
    }
    if (xout) { float4* xo = (float4*)(xout + (size_t)row * D) + lane;
#pragma unroll
        for (int j = 0; j < 4; ++j) xo[64 * j] = xv[j]; }
    if (H) {
        float s = 0.f;
#pragma unroll
        for (int j = 0; j < 4; ++j) s += xv[j].x * xv[j].x + xv[j].y * xv[j].y + xv[j].z * xv[j].z + xv[j].w * xv[j].w;
        const float rstd = rsqrtf(wave_sum(s) * (1.f / D) + EPS);
        uint2* ho = (uint2*)(H + (size_t)row * D) + lane;
#pragma unroll
        for (int j = 0; j < 4; ++j) {
            const float4 gp = ((const float4*)g_pre)[lane + 64 * j], sh = ((const float4*)shift)[lane + 64 * j], sc = ((const float4*)scale)[lane + 64 * j];
            const float a = xv[j].x * rstd * gp.x * (1.f + sc.x) + sh.x, b = xv[j].y * rstd * gp.y * (1.f + sc.y) + sh.y;
            const float c = xv[j].z * rstd * gp.z * (1.f + sc.z) + sh.z, d = xv[j].w * rstd * gp.w * (1.f + sc.w) + sh.w;
            uint2 o; o.x = (unsigned)f2bf(a) | ((unsigned)f2bf(b) << 16); o.y = (unsigned)f2bf(c) | ((unsigned)f2bf(d) << 16);
            ho[64 * j] = o;
        }
    }
}

template <int EPI>
__global__ void __launch_bounds__(256) k_gemm(const bf16* A, const bf16* Bt, void* Cout, int N, int K, int ldc) {
    __shared__ float As[16][128 + 4];
    __shared__ float Bs[16][256 + 4];
    const int tid = threadIdx.x, tx = tid & 31, ty = tid >> 5;
    const int m0 = blockIdx.y * 128, n0 = blockIdx.x * 256;
    float acc[16][8];
#pragma unroll
    for (int i = 0; i < 16; ++i)
#pragma unroll
        for (int j = 0; j < 8; ++j) acc[i][j] = 0.f;
    for (int k0 = 0; k0 < K; k0 += 16) {
        {
            const int r = tid >> 1, kh = (tid & 1) * 8;
            const uint4 v = *(const uint4*)(A + (size_t)(m0 + r) * K + k0 + kh);
            const unsigned w[4] = {v.x, v.y, v.z, v.w};
#pragma unroll
            for (int q = 0; q < 4; ++q) { As[kh + 2 * q][r] = __uint_as_float(w[q] << 16); As[kh + 2 * q + 1][r] = __uint_as_float(w[q] & 0xffff0000u); }
        }
        {
            const uint4 v0 = *(const uint4*)(Bt + (size_t)(n0 + tid) * K + k0), v1 = *(const uint4*)(Bt + (size_t)(n0 + tid) * K + k0 + 8);
            const unsigned w[8] = {v0.x, v0.y, v0.z, v0.w, v1.x, v1.y, v1.z, v1.w};
#pragma unroll
            for (int q = 0; q < 8; ++q) { Bs[2 * q][tid] = __uint_as_float(w[q] << 16); Bs[2 * q + 1][tid] = __uint_as_float(w[q] & 0xffff0000u); }
        }
        __syncthreads();
#pragma unroll
        for (int k = 0; k < 16; ++k) {
            float a[16], b[8];
#pragma unroll
            for (int i = 0; i < 16; ++i) a[i] = As[k][ty * 16 + i];
#pragma unroll
            for (int j = 0; j < 4; ++j) { b[j] = Bs[k][tx * 4 + j]; b[4 + j] = Bs[k][128 + tx * 4 + j]; }
#pragma unroll
            for (int i = 0; i < 16; ++i)
#pragma unroll
                for (int j = 0; j < 8; ++j) acc[i][j] += a[i] * b[j];
        }
        __syncthreads();
    }
#pragma unroll
    for (int i = 0; i < 16; ++i) {
        const int row = m0 + ty * 16 + i;
        if (EPI == 0) {
            bf16* C = (bf16*)Cout;
#pragma unroll
            for (int h = 0; h < 2; ++h) {
                uint2 o; o.x = (unsigned)f2bf(acc[i][4 * h]) | ((unsigned)f2bf(acc[i][4 * h + 1]) << 16); o.y = (unsigned)f2bf(acc[i][4 * h + 2]) | ((unsigned)f2bf(acc[i][4 * h + 3]) << 16);
                *(uint2*)(C + (size_t)row * ldc + n0 + 128 * h + tx * 4) = o;
            }
        } else if (EPI == 1) {
            float* C = (float*)Cout;
#pragma unroll
            for (int h = 0; h < 2; ++h) *(float4*)(C + (size_t)row * ldc + n0 + 128 * h + tx * 4) = make_float4(acc[i][4 * h], acc[i][4 * h + 1], acc[i][4 * h + 2], acc[i][4 * h + 3]);
        } else {
            bf16* C = (bf16*)Cout;
            float g[4];
#pragma unroll
            for (int j = 0; j < 4; ++j) g[j] = siluf(acc[i][j]) * acc[i][4 + j];
            uint2 o; o.x = (unsigned)f2bf(g[0]) | ((unsigned)f2bf(g[1]) << 16); o.y = (unsigned)f2bf(g[2]) | ((unsigned)f2bf(g[3]) << 16);
            *(uint2*)(C + (size_t)row * ldc + blockIdx.x * 128 + tx * 4) = o;
        }
    }
}

__global__ void k_pool(const bf16* P, const float* pool_w, const float* pool_scale, bf16* YM) {
    __shared__ float dv[16][128];
    const int g = blockIdx.y, t0 = blockIdx.x * 16, d = threadIdx.x;
    const int win = 2 << g;
    for (int tt = 0; tt < 16; ++tt) {
        const int t = t0 + tt; float s = 0.f; int cnt = 0;
        for (int i = 0; i < win; ++i) if (t - i >= 0) { s += bf2f(P[(size_t)(t - i) * HYB_IN + g * 128 + d]); ++cnt; }
        dv[tt][d] = s / (float)cnt - bf2f(P[(size_t)t * HYB_IN + g * 128 + d]);
    }
    __syncthreads();
    float acc[16];
#pragma unroll
    for (int tt = 0; tt < 16; ++tt) acc[tt] = 0.f;
    const float* w = pool_w + (size_t)g * 16384;
    for (int c = 0; c < 128; ++c) { const float wv = w[c * 128 + d];
#pragma unroll
        for (int tt = 0; tt < 16; ++tt) acc[tt] += dv[tt][c] * wv; }
    const float sc = pool_scale[g * 128 + d];
    for (int tt = 0; tt < 16; ++tt) YM[(size_t)(t0 + tt) * D + g * 128 + d] = f2bf(acc[tt] * sc);
}

__global__ void __launch_bounds__(128) k_hgrn(const bf16* P, const float* lb_logits, int layer_j, float* Oraw) {
    __shared__ float red[2][8];
    const int h = blockIdx.x, vb = blockIdx.y * 8, k = threadIdx.x, ch = h * 128 + k;
    float lb = 0.f;
    if (layer_j == 1) { const float l0 = lb_logits[ch], l1 = lb_logits[512 + ch]; lb = 1.f / (1.f + __expf(l0 - l1)); }
    float S[8];
#pragma unroll
    for (int j = 0; j < 8; ++j) S[j] = 0.f;
    for (int t = 0; t < M; ++t) {
        const bf16* pr = P + (size_t)t * HYB_IN;
        const float q = siluf(bf2f(pr[512 + ch])), z = bf2f(pr[1024 + ch]);
        const float kk = (1.f - lb) * sigmf(-z), f = 1.f - kk;
        float part[8];
#pragma unroll
        for (int j = 0; j < 8; ++j) { const float v = bf2f(pr[1536 + h * 128 + vb + j]); S[j] = f * S[j] + kk * v; part[j] = q * S[j]; }
#pragma unroll
        for (int j = 0; j < 8; ++j) part[j] = wave_sum(part[j]);
        if ((k & 63) == 0) {
#pragma unroll
            for (int j = 0; j < 8; ++j) red[k >> 6][j] = part[j];
        }
        __syncthreads();
        if (k < 8) Oraw[(size_t)t * 512 + h * 128 + vb + k] = red[0][k] + red[1][k];
        __syncthreads();
    }
}
__global__ void k_hgrn_out(const float* Oraw, const bf16* P, const float* out_gain, bf16* YM) {
    const int t = blockIdx.x * 4 + (threadIdx.x >> 6), lane = threadIdx.x & 63;
    for (int h = 0; h < 4; ++h) {
        const float o0 = Oraw[(size_t)t * 512 + h * 128 + lane], o1 = Oraw[(size_t)t * 512 + h * 128 + 64 + lane];
        const float rstd = rsqrtf(wave_sum(o0 * o0 + o1 * o1) * (1.f / 128.f) + EPS);
        const float g0 = bf2f(P[(size_t)t * HYB_IN + 2048 + h * 128 + lane]), g1 = bf2f(P[(size_t)t * HYB_IN + 2048 + h * 128 + 64 + lane]);
        YM[(size_t)t * D + 512 + h * 128 + lane] = f2bf(o0 * rstd * out_gain[lane] * siluf(g0));
        YM[(size_t)t * D + 512 + h * 128 + 64 + lane] = f2bf(o1 * rstd * out_gain[64 + lane] * siluf(g1));
    }
}

__global__ void k_attn(const bf16* QKV, const float* biastab, bf16* YM) {
    const int gid = blockIdx.x * blockDim.x + threadIdx.x;
    const int item = gid >> 2, sub = gid & 3;
    const int t = item >> 3, hh = item & 7;
    float o[16]; float mrun = -INFINITY, lrun = 0.f;
#pragma unroll
    for (int e = 0; e < 16; ++e) o[e] = 0.f;
    for (int g = 0; g < 3; ++g) {
        const int dil = g == 0 ? 1 : (g == 1 ? 4 : 16);
        float q[16];
        const bf16* qp = QKV + (size_t)t * ATT_QKV + g * 512 + hh * 64 + sub * 16;
#pragma unroll
        for (int e = 0; e < 16; ++e) q[e] = bf2f(qp[e]) * 0.125f;
        const float* bt = biastab + (g * 8 + hh) * 129;
        for (int j = 0; j <= 128; ++j) {
            const int tp = t - j * dil; if (tp < 0) break;
            const bf16* kp = QKV + (size_t)tp * ATT_QKV + 1536 + g * 512 + hh * 64 + sub * 16;
            const bf16* vp = kp + 1536;
            float s = 0.f;
#pragma unroll
            for (int e = 0; e < 16; ++e) s += q[e] * bf2f(kp[e]);
            s += __shfl_xor(s, 1); s += __shfl_xor(s, 2);
            s += bt[j];
            const float mn = fmaxf(mrun, s), al = __expf(mrun - mn), p = __expf(s - mn);
            lrun = lrun * al + p;
#pragma unroll
            for (int e = 0; e < 16; ++e) o[e] = o[e] * al + p * bf2f(vp[e]);
            mrun = mn;
        }
    }
    const float inv = 1.f / lrun;
    bf16* op = YM + (size_t)t * 512 + hh * 64 + sub * 16;
#pragma unroll
    for (int e = 0; e < 16; ++e) op[e] = f2bf(o[e] * inv);
}

extern "C" void kernel_launch(void* const* d_in, const int* in_sizes, int n_in, void* d_out, int out_size, void* d_ws, size_t ws_size, hipStream_t stream) {
    if (n_in != 17 || in_sizes[0] != M * D || out_size != M * D || ws_size < WS_END) {
        fprintf(stderr, "kernel_launch: unexpected shapes: n_in %d in0 %d out %d ws %zu (need %zu)\n", n_in, n_in > 0 ? in_sizes[0] : -1, out_size, ws_size, (size_t)WS_END);
        return;
    }
    const float* x = (const float*)d_in[0]; const float* c = (const float*)d_in[1]; const float* ada_w = (const float*)d_in[2]; const float* ada_b = (const float*)d_in[3];
    const float* norm_pre = (const float*)d_in[4]; const float* norm_post = (const float*)d_in[5]; const float* ffn_w_in = (const float*)d_in[6]; const float* ffn_w_out = (const float*)d_in[7];
    const float* hyb_w_in = (const float*)d_in[8]; const float* hyb_w_out = (const float*)d_in[9]; const float* pool_w = (const float*)d_in[10]; const float* pool_scale = (const float*)d_in[11];
    const float* lb_logits = (const float*)d_in[12]; const float* out_norm = (const float*)d_in[13]; const float* att_w_qkv = (const float*)d_in[14]; const float* att_w_out = (const float*)d_in[15];
    const float* rel_bias = (const float*)d_in[16];
    unsigned char* ws = (unsigned char*)d_ws; float* out = (float*)d_out;
    float* mod = (float*)(ws + WS_MOD); float* biastab = (float*)(ws + WS_BIAS);
    bf16* wfi = (bf16*)(ws + WS_WFI); bf16* wfo = (bf16*)(ws + WS_WFO); bf16* whi = (bf16*)(ws + WS_WHI); bf16* who = (bf16*)(ws + WS_WHO);
    bf16* wqkv = (bf16*)(ws + WS_WQKV); bf16* wao = (bf16*)(ws + WS_WAO);
    bf16* H = (bf16*)(ws + WS_H); bf16* P = (bf16*)(ws + WS_P); bf16* YM = (bf16*)(ws + WS_YM); float* Y = (float*)(ws + WS_Y); float* Oraw = (float*)(ws + WS_ORAW);
    (void)pool_w;
    const dim3 tb(32, 8);
    k_wconv<1><<<dim3(5632 / 32, 1024 / 32, 4), tb, 0, stream>>>(ffn_w_in, wfi, 1024, 5632, (size_t)1024 * 5632, (size_t)5632 * 1024);
    k_wconv<0><<<dim3(1024 / 32, 2816 / 32, 4), tb, 0, stream>>>(ffn_w_out, wfo, 2816, 1024, (size_t)2816 * 1024, (size_t)1024 * 2816);
    k_wconv<0><<<dim3(2560 / 32, 1024 / 32, 2), tb, 0, stream>>>(hyb_w_in, whi, 1024, 2560, (size_t)1024 * 2560, (size_t)2560 * 1024);
    k_wconv<0><<<dim3(1024 / 32, 1024 / 32, 2), tb, 0, stream>>>(hyb_w_out, who, 1024, 1024, (size_t)1024 * 1024, (size_t)1024 * 1024);
    k_wconv<0><<<dim3(4608 / 32, 1024 / 32, 2), tb, 0, stream>>>(att_w_qkv, wqkv, 1024, 4608, (size_t)1024 * 4608, (size_t)4608 * 1024);
    k_wconv<0><<<dim3(1024 / 32, 512 / 32, 2), tb, 0, stream>>>(att_w_out, wao, 512, 1024, (size_t)512 * 1024, (size_t)1024 * 512);
    k_mod<<<24576 / 256, 256, 0, stream>>>(c, ada_w, ada_b, mod);
    k_biastab<<<(24 * 129 + 255) / 256, 256, 0, stream>>>(rel_bias, biastab);
#define MODP(l, s, part) (mod + ((l) * 2 + (s)) * 3072 + (part) * 1024)
    k_row<<<M / 4, 256, 0, stream>>>(x, nullptr, out, H, nullptr, nullptr, norm_pre + 0, MODP(0, 0, 0), MODP(0, 0, 1));
    for (int l = 0; l < DEPTH; ++l) {
        const int j = l / 2;
        if (l % 2 == 0) {
            k_gemm<0><<<dim3(HYB_IN / 256, M / 128), 256, 0, stream>>>(H, whi + (size_t)j * 2560 * 1024, P, HYB_IN, 1024, HYB_IN);
            k_pool<<<dim3(M / 16, 4), 128, 0, stream>>>(P, pool_w + (size_t)j * 4 * 16384, pool_scale + j * 512, YM);
            k_hgrn<<<dim3(4, 16), 128, 0, stream>>>(P, lb_logits, j, Oraw);
            k_hgrn_out<<<M / 4, 256, 0, stream>>>(Oraw, P, out_norm + j * 128, YM);
            k_gemm<1><<<dim3(D / 256, M / 128), 256, 0, stream>>>(YM, who + (size_t)j * 1024 * 1024, Y, D, 1024, D);
        } else {
            k_gemm<0><<<dim3(ATT_QKV / 256, M / 128), 256, 0, stream>>>(H, wqkv + (size_t)j * 4608 * 1024, P, ATT_QKV, 1024, ATT_QKV);
            k_attn<<<M * 8 * 4 / 256, 256, 0, stream>>>(P, biastab, YM);
            k_gemm<1><<<dim3(D / 256, M / 128), 256, 0, stream>>>(YM, wao + (size_t)j * 1024 * 512, Y, D, 512, D);
        }
        k_row<<<M / 4, 256, 0, stream>>>(out, Y, out, H, MODP(l, 0, 2), norm_post + (l * 2 + 0) * D, norm_pre + (l * 2 + 1) * D, MODP(l, 1, 0), MODP(l, 1, 1));
        k_gemm<2><<<dim3(5632 / 256, M / 128), 256, 0, stream>>>(H, wfi + (size_t)l * 5632 * 1024, P, 5632, 1024, DFF);
        k_gemm<1><<<dim3(D / 256, M / 128), 256, 0, stream>>>(P, wfo + (size_t)l * 1024 * 2816, Y, D, DFF, D);
        if (l + 1 < DEPTH)
            k_row<<<M / 4, 256, 0, stream>>>(out, Y, out, H, MODP(l, 1, 2), norm_post + (l * 2 + 1) * D, norm_pre + ((l + 1) * 2 + 0) * D, MODP(l + 1, 0, 0), MODP(l + 1, 0, 1));
        else
            k_row<<<M / 4, 256, 0, stream>>>(out, Y, out, nullptr, MODP(l, 1, 2), norm_post + (l * 2 + 1) * D, nullptr, nullptr, nullptr);
    }
}
```

```cpp
#include <hip/hip_runtime.h>
#include <cstdio>
#include <cstdint>
namespace pg8 {
#define PG8_LAS __attribute__((address_space(3)))
typedef unsigned short bf16_t;
typedef short bf16x8 __attribute__((ext_vector_type(8)));
typedef float f32x4 __attribute__((ext_vector_type(4)));
typedef unsigned u32x4 __attribute__((ext_vector_type(4)));
constexpr int BM = 256, BK = 64, HALF = 128, HTB = HALF * BK * 2  , STAGE_BYTES = 8 * HTB, NXCD = 8, WGM = 8;

__host__ __device__ __forceinline__ int lds_byte(int r, int c) { const int st = (r >> 4) * 2 + (c >> 5), rr = r & 15, cc = c & 31, ob = rr * 64 + cc * 2; return st * 1024 + (ob ^ (((ob >> 9) & 1) << 5)); }
__host__ __device__ __forceinline__ void stage_rc(int b, int& R, int& C) { const int st = b / 1024, sb = b % 1024, swz = sb ^ (((sb >> 9) & 1) << 5); R = (st >> 1) * 16 + swz / 64; C = (st & 1) * 32 + (swz % 64) / 2; }
__host__ __device__ __forceinline__ int perm32(int rho) { const int n = rho >> 4, i = rho & 15; return 8 * (i >> 2) + 4 * n + (i & 3); }

struct Unit { int pm, pn; };
struct Gemm { const bf16_t* A; const bf16_t* Bt; int M, N, K; };

struct StaticOrder {
    int nM, nN, nwg, G, c;
    __host__ __device__ void init(int M, int N, int G_, int c_) { nM = M / BM; nN = N / BM; nwg = nM * nN; G = G_; c = c_; }
    __host__ __device__ bool next(int i, Unit& u) const {
        const long L = (long)i * G + c; if (L >= nwg) return false;
        int wgid = (int)L; { const int q = nwg / NXCD, r = nwg % NXCD, xcd = wgid % NXCD, off = wgid / NXCD; wgid = (xcd < r ? xcd * (q + 1) : r * (q + 1) + (xcd - r) * q) + off; }
        const int nig = WGM * nN, gid = wgid / nig, fm = gid * WGM, gsz = (nM - fm) < WGM ? (nM - fm) : WGM;
        u.pm = fm + ((wgid % nig) % gsz); u.pn = (wgid % nig) / gsz; return true;
    }
    __device__ __forceinline__ void a_ready(const Unit&) const {}
    __device__ __forceinline__ void done(const Unit&) const {}
};

__device__ __forceinline__ unsigned cvt_pk_bf16(float lo, float hi) { unsigned r; asm volatile("v_cvt_pk_bf16_f32 %0, %1, %2" : "=v"(r) : "v"(lo), "v"(hi)); return r; }
__device__ __forceinline__ float silu_f(float v) { return v * __builtin_amdgcn_rcpf(1.0f + __expf(-v)); }
struct EpiBf16 {
    static constexpr bool PERM = true, AFTER_DRAIN = false;
    bf16_t* O; int ldc;
    __device__ __forceinline__ void operator()(const f32x4 (&acc)[2][2][4][2], const Unit& u, int wr, int wc, int fr, int fq) const {
        const int row0 = u.pm * BM + wr * 64 + fr, col0 = u.pn * BM + wc * 32 + 8 * fq;
#pragma unroll
        for (int ai = 0; ai < 2; ++ai)
#pragma unroll
            for (int m = 0; m < 4; ++m) { bf16_t* rowp = O + (size_t)(row0 + ai * HALF + m * 16) * ldc + col0;
#pragma unroll
                for (int bj = 0; bj < 2; ++bj) { const f32x4 v0 = acc[ai][bj][m][0], v1 = acc[ai][bj][m][1];
                    u32x4 w; w.x = cvt_pk_bf16(v0[0], v0[1]); w.y = cvt_pk_bf16(v0[2], v0[3]); w.z = cvt_pk_bf16(v1[0], v1[1]); w.w = cvt_pk_bf16(v1[2], v1[3]);
                    *(u32x4*)(rowp + bj * HALF) = w; } }
    }
};
struct EpiSwiglu {
    static constexpr bool PERM = true, AFTER_DRAIN = false;
    bf16_t* O; int ldc;
    __device__ __forceinline__ void operator()(const f32x4 (&acc)[2][2][4][2], const Unit& u, int wr, int wc, int fr, int fq) const {
        const int row0 = u.pm * BM + wr * 64 + fr, col0 = u.pn * HALF + wc * 32 + 8 * fq;
#pragma unroll
        for (int ai = 0; ai < 2; ++ai)
#pragma unroll
            for (int m = 0; m < 4; ++m) { bf16_t* rowp = O + (size_t)(row0 + ai * HALF + m * 16) * ldc + col0;
                const f32x4 a0 = acc[ai][0][m][0], a1 = acc[ai][0][m][1], b0 = acc[ai][1][m][0], b1 = acc[ai][1][m][1];
                u32x4 w; w.x = cvt_pk_bf16(silu_f(a0[0]) * b0[0], silu_f(a0[1]) * b0[1]); w.y = cvt_pk_bf16(silu_f(a0[2]) * b0[2], silu_f(a0[3]) * b0[3]);
                w.z = cvt_pk_bf16(silu_f(a1[0]) * b1[0], silu_f(a1[1]) * b1[1]); w.w = cvt_pk_bf16(silu_f(a1[2]) * b1[2], silu_f(a1[3]) * b1[3]);
                *(u32x4*)rowp = w; }
    }
};
struct EpiF32 {
    static constexpr bool PERM = false, AFTER_DRAIN = false;
    float* C; int ldc;
    __device__ __forceinline__ void operator()(const f32x4 (&acc)[2][2][4][2], const Unit& u, int wr, int wc, int fr, int fq) const {
        const int row0 = u.pm * BM + wr * 64 + fr, col0 = u.pn * BM + wc * 32 + 4 * fq;
#pragma unroll
        for (int ai = 0; ai < 2; ++ai)
#pragma unroll
            for (int m = 0; m < 4; ++m) { float* rowp = C + (size_t)(row0 + ai * HALF + m * 16) * ldc + col0;
#pragma unroll
                for (int bj = 0; bj < 2; ++bj)
#pragma unroll
                    for (int n = 0; n < 2; ++n) *(f32x4*)(rowp + bj * HALF + n * 16) = acc[ai][bj][m][n]; }
    }
};
template <class Epi, class Sched, bool ALIGN_EPI = false, bool SP2 = false, int KC = 0>
__device__ __forceinline__ void gemm_phase(PG8_LAS unsigned char* lds, const Gemm g, const Sched& S, const Epi& E) {
    const int tid = threadIdx.x, wid = __builtin_amdgcn_readfirstlane(tid >> 6), lane = tid & 63, wr = wid >> 2, wc = wid & 3, fr = lane & 15, fq = lane >> 4;
    const int K = KC ? KC : g.K, nt = K / BK;
    unsigned voffA[2], voffB[2];
#pragma unroll
    for (int i = 0; i < 2; ++i) { int R, C; stage_rc(tid * 16 + i * 8192, R, C); const int Rb = Epi::PERM ? ((R & ~31) + perm32(R & 31)) : R;
        voffA[i] = (unsigned)(R * K + C) * 2u; voffB[i] = (unsigned)(Rb * K + C) * 2u; }
    const size_t kstep = (size_t)(BK * 2);
    const size_t hstep = (size_t)HALF * K * 2;
    const size_t tstep = 2 * hstep;
    const unsigned ldsw = (unsigned)wid * 1024u;
    const int aoff = lds_byte(wr * 64 + fr, fq * 8), boff = lds_byte(wc * 32 + fr, fq * 8);
#define PG8_SA(b, h) (((b) * 2 + (h)) * HTB)
#define PG8_SB(b, h) ((4 + (b) * 2 + (h)) * HTB)
#define PG8_STAGE(bufoff, gbase, voff) do { _Pragma("unroll") for (int _i = 0; _i < 2; ++_i) \
        __builtin_amdgcn_global_load_lds((const unsigned*)((const char*)(gbase) + (voff)[_i]), (PG8_LAS unsigned*)(lds + (bufoff) + ldsw + _i * 8192), 16, 0, 0); } while (0)
#define PG8_LDA(dst, b, h) do { _Pragma("unroll") for (int m = 0; m < 4; ++m) _Pragma("unroll") for (int k = 0; k < 2; ++k) dst[m][k] = *(const PG8_LAS bf16x8*)(lds + PG8_SA(b, h) + aoff + m * 2048 + k * 1024); } while (0)
#define PG8_LDB(dst, b, h) do { _Pragma("unroll") for (int n = 0; n < 2; ++n) _Pragma("unroll") for (int k = 0; k < 2; ++k) dst[n][k] = *(const PG8_LAS bf16x8*)(lds + PG8_SB(b, h) + boff + n * 2048 + k * 1024); } while (0)
#define PG8_MMA(ai, bj, At, Bt) do { __builtin_amdgcn_s_setprio(1); _Pragma("unroll") for (int m = 0; m < 4; ++m) _Pragma("unroll") for (int n = 0; n < 2; ++n) _Pragma("unroll") for (int k = 0; k < 2; ++k) \
        acc[ai][bj][m][n] = __builtin_amdgcn_mfma_f32_16x16x32_bf16(Bt[n][k], At[m][k], acc[ai][bj][m][n], 0, 0, 0); __builtin_amdgcn_s_setprio(0); } while (0)
#define PG8_WAIT_V(n) asm volatile("s_waitcnt vmcnt(" #n ")" ::: "memory")
#define PG8_WAIT_L(n) asm volatile("s_waitcnt lgkmcnt(" #n ")" ::: "memory")
#define PG8_BAR __builtin_amdgcn_s_barrier()
#define PG8_SCHED __builtin_amdgcn_sched_barrier(0)
    Unit cur, nxt; int ui = 0;
    if (!S.next(0, cur)) return;
    f32x4 acc[2][2][4][2];
#pragma unroll
    for (int a = 0; a < 2; ++a)
#pragma unroll
        for (int b = 0; b < 2; ++b)
#pragma unroll
            for (int m = 0; m < 4; ++m)
#pragma unroll
                for (int n = 0; n < 2; ++n) acc[a][b][m][n] = (f32x4){0.f, 0.f, 0.f, 0.f};
    bf16x8 At[4][2], B0[2][2], B1[2][2];
    const char* cA = (const char*)g.A + (size_t)cur.pm * tstep; const char* cB = (const char*)g.Bt + (size_t)cur.pn * tstep;
    S.a_ready(cur);
    if constexpr (SP2) {
        PG8_STAGE(PG8_SB(0, 0), cB, voffB); PG8_STAGE(PG8_SB(0, 1), cB + hstep, voffB); PG8_STAGE(PG8_SA(0, 0), cA, voffA); PG8_STAGE(PG8_SA(0, 1), cA + hstep, voffA);
        if (wr == 1) PG8_BAR;
        PG8_WAIT_V(2); PG8_BAR;
        PG8_STAGE(PG8_SB(1, 0), cB + kstep, voffB); PG8_STAGE(PG8_SA(1, 0), cA + kstep, voffA); PG8_STAGE(PG8_SB(1, 1), cB + hstep + kstep, voffB);
        PG8_WAIT_V(6); PG8_BAR;
    } else {
        PG8_STAGE(PG8_SB(0, 0), cB, voffB); PG8_STAGE(PG8_SA(0, 0), cA, voffA); PG8_STAGE(PG8_SB(0, 1), cB + hstep, voffB); PG8_STAGE(PG8_SA(0, 1), cA + hstep, voffA);
        if (wr == 1) PG8_BAR;
        PG8_WAIT_V(4); PG8_BAR;
        PG8_STAGE(PG8_SB(1, 0), cB + kstep, voffB); PG8_STAGE(PG8_SA(1, 0), cA + kstep, voffA); PG8_STAGE(PG8_SB(1, 1), cB + hstep + kstep, voffB);
        PG8_WAIT_V(6); PG8_BAR;
    }
    for (;;) {
        const bool has_next = S.next(ui + 1, nxt);
        const char* nA = has_next ? (const char*)g.A + (size_t)nxt.pm * tstep : cA; const char* nB = has_next ? (const char*)g.Bt + (size_t)nxt.pn * tstep : cB;
        for (int t = 0; t < nt; t += 2) {
            const bool last = (t == nt - 2);
            const char* a1 = cA + (size_t)(t + 1) * kstep;
            const char* a2 = last ? nA : cA + (size_t)(t + 2) * kstep; const char* b2 = last ? nB : cB + (size_t)(t + 2) * kstep;
            const char* a3 = a2 + kstep; const char* b3 = b2 + kstep;
            if (last && has_next) S.a_ready(nxt);
            if constexpr (SP2) {
            PG8_LDB(B0, 0, 0); PG8_LDB(B1, 0, 1); PG8_SCHED; PG8_LDA(At, 0, 0); PG8_STAGE(PG8_SA(1, 1), a1 + hstep, voffA);
            PG8_WAIT_V(8); PG8_WAIT_L(0); PG8_BAR; PG8_MMA(0, 0, At, B0); PG8_MMA(0, 1, At, B1); PG8_BAR; PG8_SCHED;
            PG8_LDA(At, 0, 1); PG8_STAGE(PG8_SB(0, 0), b2, voffB); PG8_STAGE(PG8_SB(0, 1), b2 + hstep, voffB); PG8_STAGE(PG8_SA(0, 0), a2, voffA);
            PG8_WAIT_V(8); PG8_WAIT_L(0); PG8_BAR; PG8_MMA(1, 0, At, B0); PG8_MMA(1, 1, At, B1); PG8_BAR; PG8_SCHED;
            PG8_LDB(B0, 1, 0); PG8_LDB(B1, 1, 1); PG8_SCHED; PG8_LDA(At, 1, 0); PG8_STAGE(PG8_SA(0, 1), a2 + hstep, voffA);
            PG8_WAIT_V(8); PG8_WAIT_L(0); PG8_BAR; PG8_MMA(0, 0, At, B0); PG8_MMA(0, 1, At, B1); PG8_BAR; PG8_SCHED;
            PG8_LDA(At, 1, 1); PG8_STAGE(PG8_SB(1, 0), b3, voffB); PG8_STAGE(PG8_SB(1, 1), b3 + hstep, voffB); PG8_STAGE(PG8_SA(1, 0), a3, voffA);
            PG8_WAIT_V(8); PG8_WAIT_L(0); PG8_BAR; PG8_MMA(1, 0, At, B0); PG8_MMA(1, 1, At, B1); PG8_BAR; PG8_SCHED;
            } else {
            PG8_LDB(B0, 0, 0); PG8_SCHED; PG8_LDA(At, 0, 0); PG8_STAGE(PG8_SA(1, 1), a1 + hstep, voffA);
            PG8_WAIT_L(8); PG8_BAR; PG8_WAIT_L(0); PG8_MMA(0, 0, At, B0); PG8_BAR; PG8_SCHED;
            PG8_LDB(B1, 0, 1); PG8_STAGE(PG8_SB(0, 0), b2, voffB);
            PG8_BAR; PG8_WAIT_L(0); PG8_MMA(0, 1, At, B1); PG8_BAR;
            PG8_LDA(At, 0, 1); PG8_STAGE(PG8_SA(0, 0), a2, voffA);
            PG8_BAR; PG8_WAIT_L(0); PG8_MMA(1, 0, At, B0); PG8_BAR; PG8_SCHED;
            PG8_STAGE(PG8_SB(0, 1), b2 + hstep, voffB);
            PG8_WAIT_V(6); PG8_BAR; PG8_MMA(1, 1, At, B1); PG8_BAR;
            PG8_LDB(B0, 1, 0); PG8_SCHED; PG8_LDA(At, 1, 0); PG8_STAGE(PG8_SA(0, 1), a2 + hstep, voffA);
            PG8_WAIT_L(8); PG8_BAR; PG8_WAIT_L(0); PG8_MMA(0, 0, At, B0); PG8_BAR; PG8_SCHED;
            PG8_LDB(B1, 1, 1); PG8_STAGE(PG8_SB(1, 0), b3, voffB);
            PG8_BAR; PG8_WAIT_L(0); PG8_MMA(0, 1, At, B1); PG8_BAR;
            PG8_LDA(At, 1, 1); PG8_STAGE(PG8_SA(1, 0), a3, voffA);
            PG8_BAR; PG8_WAIT_L(0); PG8_MMA(1, 0, At, B0); PG8_BAR; PG8_SCHED;
            PG8_STAGE(PG8_SB(1, 1), b3 + hstep, voffB);
            PG8_WAIT_V(6); PG8_BAR; PG8_MMA(1, 1, At, B1); PG8_BAR;
            }
        }
        if constexpr (ALIGN_EPI) { if (wr == 0) PG8_BAR; }
        if constexpr (!Epi::AFTER_DRAIN) { E(acc, cur, wr, wc, fr, fq); S.done(cur); }
        if (!has_next) break;
#pragma unroll
        for (int a = 0; a < 2; ++a)
#pragma unroll
            for (int b = 0; b < 2; ++b)
#pragma unroll
                for (int m = 0; m < 4; ++m)
#pragma unroll
                    for (int n = 0; n < 2; ++n) acc[a][b][m][n] = (f32x4){0.f, 0.f, 0.f, 0.f};
        cur = nxt; cA = nA; cB = nB; ++ui;
        if constexpr (ALIGN_EPI) { if (wr == 1) PG8_BAR; }
    }
    PG8_WAIT_V(0);
    if constexpr (!ALIGN_EPI) { if (wr == 0) PG8_BAR; }
    PG8_BAR;
    if constexpr (Epi::AFTER_DRAIN) { E.fused(acc, cur, wr, wc, fr, fq, lds, wid, lane); S.done(cur); }
#undef PG8_SA
#undef PG8_SB
#undef PG8_STAGE
#undef PG8_LDA
#undef PG8_LDB
#undef PG8_MMA
#undef PG8_WAIT_V
#undef PG8_WAIT_L
#undef PG8_BAR
#undef PG8_SCHED
}
}
#ifndef PG8_SP2
#define PG8_SP2 true
#endif
#ifndef PG8_ALIGN
#define PG8_ALIGN true
#endif
constexpr int NWAVES = 8;
constexpr int M = 16384, D = 1024, DEPTH = 4, DFF = 2816, HYB_IN = 2560, ATT_QKV = 4608;
constexpr float EPS = 1e-6f;
constexpr size_t MiB = 1u << 20;
constexpr size_t WS_CTL = 0, CTL_ZERO_BYTES = 1 * MiB;
constexpr size_t WS_MOD = 1 * MiB;
constexpr size_t WS_BIAS = 1 * MiB + 256 * 1024;
constexpr size_t WS_DSEG = 1 * MiB + 512 * 1024;
constexpr size_t WS_WFI = 2 * MiB, WS_WFO = 46 * MiB, WS_WHI = 68 * MiB, WS_WHO = 78 * MiB, WS_WQKV = 82 * MiB, WS_WAO = 100 * MiB;
constexpr size_t WS_MODP = 102 * MiB;
constexpr size_t WS_H = 104 * MiB;
constexpr size_t WS_P = 136 * MiB;
constexpr size_t WS_YM = 280 * MiB;
constexpr size_t WS_Y = 312 * MiB;
constexpr size_t WS_SLOC = 312 * MiB, WS_SIN = 328 * MiB;
constexpr size_t WS_ORAW = 344 * MiB;
constexpr size_t WS_END = 376 * MiB;
constexpr int CW_TMO = 0, CW_CODE = 1, CW_BAR = 4096, MAX_LAUNCHES = 16;
constexpr int LDS_BYTES = 163840, MISC_OFF = LDS_BYTES - 512, PTR_OFF = LDS_BYTES - 256;
#define GAS __attribute__((address_space(1)))
#define LAS __attribute__((address_space(3)))
typedef unsigned short bf16;
typedef unsigned v4u __attribute__((ext_vector_type(4)));
typedef float f32x4 __attribute__((ext_vector_type(4)));
typedef short bf16x8 __attribute__((ext_vector_type(8)));
typedef GAS unsigned gu32;
typedef GAS unsigned long long gu64;
#define RLX_AGENT __ATOMIC_RELAXED, __HIP_MEMORY_SCOPE_AGENT
#define LDS_WAIT() asm volatile("s_waitcnt lgkmcnt(0)" ::: "memory")
#define VM_WAIT() asm volatile("s_waitcnt vmcnt(0)" ::: "memory")
__device__ __forceinline__ unsigned long long rt() { return __builtin_amdgcn_s_memrealtime(); }
__device__ __forceinline__ unsigned f2bf(float f) { unsigned u = __builtin_bit_cast(unsigned, f); return (u + 0x7fffu + ((u >> 16) & 1u)) >> 16; }
__device__ __forceinline__ unsigned pk2(float lo, float hi) { return f2bf(lo) | (f2bf(hi) << 16); }

#define XB_TMO      128
#define XB_XCNT(j)  (256  + 64 * (j))
#define XB_XSUB(j)  (1280 + 64 * (j))
#define XB_XGEN(j)  (2304 + 64 * (j))
#define XB_TOP      3328
#define XB_TOPGEN   3392
#define XCD_BAR_WORDS 3456
#define XB_SPIN_CAP (1u << 18)

__device__ __forceinline__ unsigned xb_ld(unsigned* p)              { return __hip_atomic_load(p, __ATOMIC_RELAXED, __HIP_MEMORY_SCOPE_AGENT); }
__device__ __forceinline__ unsigned xb_add(unsigned* p, unsigned v) { return __hip_atomic_fetch_add(p, v, __ATOMIC_RELAXED, __HIP_MEMORY_SCOPE_AGENT); }
__device__ __forceinline__ unsigned xb_xcc_id() { return (unsigned)__builtin_amdgcn_s_getreg((3 << 11) | 20) & 0xFu; }
#define XB_SPIN(cond, bar) do { unsigned _sp = 0; while (cond) { __builtin_amdgcn_s_sleep(1); \
    if ((++_sp & 255u) == 0u) { if (xb_ld(&(bar)[XB_TMO])) break; if (_sp > XB_SPIN_CAP) { atomicAdd(&(bar)[XB_TMO], 1u); break; } } } } while (0)

struct XcdBarrier {
    unsigned* bar; unsigned x;
    volatile LAS unsigned* st;
};

__device__ __forceinline__ XcdBarrier xcd_barrier_post(unsigned* bar, volatile LAS unsigned* st) {
    XcdBarrier b; b.bar = bar; b.x = xb_xcc_id(); b.st = st;
    if (threadIdx.x == 0) (void)xb_add(&bar[XB_XCNT(b.x)], 1u);
    return b;
}
__device__ __forceinline__ void xcd_barrier_complete(unsigned* bar, unsigned x, unsigned& nloc, unsigned& nx) {
    const unsigned G = gridDim.x * gridDim.y * gridDim.z;
    unsigned sum, cnt, mine, sp = 0u;
    for (;;) {
        sum = 0u; cnt = 0u; mine = 0u;
#pragma unroll
        for (unsigned j = 0; j < 16; ++j) { const unsigned c = xb_ld(&bar[XB_XCNT(j)]); sum += c; cnt += (c > 0u) ? 1u : 0u; mine = (j == x) ? c : mine; }
        if (sum == G) break;
        __builtin_amdgcn_s_sleep(1);
        if ((++sp & 255u) == 0u) { if (xb_ld(&bar[XB_TMO])) break; if (sp > XB_SPIN_CAP) { atomicAdd(&bar[XB_TMO], 1u); break; } }
    }
    nloc = mine > 0u ? mine : 1u; nx = cnt > 0u ? cnt : 1u;
}

__device__ __forceinline__ void xcd_barrier(const XcdBarrier& b) {
    asm volatile("s_waitcnt vmcnt(0)" ::: "memory");
    __syncthreads();
    if (threadIdx.x == 0) {
        unsigned* bar = b.bar;
        __builtin_amdgcn_s_waitcnt(0);
        unsigned nloc = b.st[0], nx = b.st[1];
        if (nloc == 0u) { xcd_barrier_complete(bar, b.x, nloc, nx); b.st[0] = nloc; b.st[1] = nx; }
        const unsigned old = xb_add(&bar[XB_XSUB(b.x)], 1u);
        const unsigned gen = old / nloc;
        if (old + 1u == (gen + 1u) * nloc) {
            __builtin_amdgcn_fence(__ATOMIC_RELEASE, "agent");
            asm volatile("s_waitcnt vmcnt(0)" ::: "memory");
            const unsigned og = xb_add(&bar[XB_TOP], 1u);
            const unsigned tg = og / nx;
            if (og + 1u == (tg + 1u) * nx) xb_add(&bar[XB_TOPGEN], 1u);
            else XB_SPIN(xb_ld(&bar[XB_TOPGEN]) == tg, bar);
            __builtin_amdgcn_fence(__ATOMIC_ACQUIRE, "agent");
            xb_add(&bar[XB_XGEN(b.x)], 1u);
            asm volatile("s_waitcnt vmcnt(0)" ::: "memory");
        } else {
            XB_SPIN(xb_ld(&bar[XB_XGEN(b.x)]) == gen, bar);
            __builtin_amdgcn_fence(__ATOMIC_ACQUIRE, "agent");
            asm volatile("s_waitcnt vmcnt(0)" ::: "memory");
        }
    }
    __syncthreads();
}
struct Frame {
    LAS unsigned char* lds;
    volatile LAS unsigned* MISC;
    gu32* ctl;
    int tid, lane, wave, vcu, G;
};
__device__ __forceinline__ float wave_sum(float v) {
#pragma unroll
    for (int o = 1; o < 64; o <<= 1) v += __shfl_xor(v, o);
    return v;
}
__device__ __forceinline__ float silu_f(float v) { return v * __builtin_amdgcn_rcpf(1.0f + __expf(-v)); }
__device__ __forceinline__ int opaque(int v) { asm volatile("" : "+v"(v)); return v; }
__device__ __forceinline__ float bf2f(bf16 b) { return __uint_as_float(((unsigned)b) << 16); }

__device__ __forceinline__ void p0_transpose_item(const float* W, int K, int N, bf16* WT, int mode, LAS float* scr, int item, int lane) {
    const int nblk = N / 32, kb = item / nblk, nb = item % nblk, k0 = 64 * kb, n0 = 32 * nb;
    int src_n0 = n0;
    if (mode == 1) { const int tile = n0 >> 8, r = n0 & 255; src_n0 = (r < 128) ? tile * 128 + r : DFF + tile * 128 + (r - 128); }
#pragma unroll 8
    for (int i = 0; i < 32; ++i) { const int kk = 2 * i + (lane >> 5); scr[kk * 33 + (lane & 31)] = W[(size_t)(k0 + kk) * N + src_n0 + (lane & 31)]; }
    LDS_WAIT(); asm volatile("" ::: "memory");
    const int c = lane & 7;
#pragma unroll
    for (int j = 0; j < 4; ++j) { const int n = (lane >> 3) + 8 * j; const LAS float* s = scr + (8 * c) * 33 + n;
        v4u o; o.x = pk2(s[0 * 33], s[1 * 33]); o.y = pk2(s[2 * 33], s[3 * 33]); o.z = pk2(s[4 * 33], s[5 * 33]); o.w = pk2(s[6 * 33], s[7 * 33]);
        *(GAS v4u*)(WT + (size_t)(n0 + n) * K + k0 + 8 * c) = o; }
    LDS_WAIT(); asm volatile("" ::: "memory");
}
__device__ __forceinline__ int t5_bucket(int d) {
    if (d < 16) return d;
    const int large = 16 + (int)(logf((float)d / 16.f) / 4.852030263919617f * 16.f);
    return large < 31 ? large : 31;
}
enum InIdx { IN_X = 0, IN_C, IN_ADA_W, IN_ADA_B, IN_NORM_PRE, IN_NORM_POST, IN_FFN_W_IN, IN_FFN_W_OUT, IN_HYB_W_IN, IN_HYB_W_OUT, IN_POOL_W, IN_POOL_SCALE, IN_LB_LOGITS, IN_OUT_NORM, IN_ATT_W_QKV, IN_ATT_W_OUT, IN_REL_BIAS };
__device__ __forceinline__ const float* inptr(const Frame& F, int i) {
    const unsigned long long v = ((volatile LAS unsigned long long*)(F.lds + PTR_OFF))[i];
    return (const float*)(((unsigned long long)(unsigned)__builtin_amdgcn_readfirstlane((int)(unsigned)(v >> 32)) << 32) | (unsigned long long)(unsigned)__builtin_amdgcn_readfirstlane((int)(unsigned)v));
}
struct In { const float *x, *c, *ada_w, *ada_b, *norm_pre, *norm_post, *ffn_w_in, *ffn_w_out, *hyb_w_in, *hyb_w_out, *pool_w, *pool_scale, *lb_logits, *out_norm, *att_w_qkv, *att_w_out, *rel_bias; };
__device__ __forceinline__ In load_in(const Frame& F) { In I; I.x = inptr(F, 0); I.c = inptr(F, 1); I.ada_w = inptr(F, 2); I.ada_b = inptr(F, 3); I.norm_pre = inptr(F, 4); I.norm_post = inptr(F, 5); I.ffn_w_in = inptr(F, 6); I.ffn_w_out = inptr(F, 7);
    I.hyb_w_in = inptr(F, 8); I.hyb_w_out = inptr(F, 9); I.pool_w = inptr(F, 10); I.pool_scale = inptr(F, 11); I.lb_logits = inptr(F, 12); I.out_norm = inptr(F, 13); I.att_w_qkv = inptr(F, 14); I.att_w_out = inptr(F, 15); I.rel_bias = inptr(F, 16); return I; }

typedef float f32x2 __attribute__((ext_vector_type(2)));
constexpr int HG_QT = 0, HG_KH = 8704, HG_KDT = 17408, HG_VT = 27648, HG_AM = 37888, HG_WT = 40448, HG_D = 44544, HG_O = 45056, HG_END = 61952;
constexpr int HG_RS = 272  , HG_TS = 80  , HG_OS = 528  ;
__device__ __forceinline__ unsigned cvtpk(float lo, float hi) { unsigned r; asm volatile("v_cvt_pk_bf16_f32 %0, %1, %2" : "=v"(r) : "v"(lo), "v"(hi)); return r; }
__device__ __forceinline__ void unpack8(const v4u r, float (&f)[8]) {
    f[0] = __uint_as_float(r.x << 16); f[1] = __uint_as_float(r.x & 0xffff0000u); f[2] = __uint_as_float(r.y << 16); f[3] = __uint_as_float(r.y & 0xffff0000u);
    f[4] = __uint_as_float(r.z << 16); f[5] = __uint_as_float(r.z & 0xffff0000u); f[6] = __uint_as_float(r.w << 16); f[7] = __uint_as_float(r.w & 0xffff0000u);
}
__device__ __forceinline__ bf16x8 pack8(const f32x4 a, const f32x4 b) {
    v4u r; r.x = cvtpk(a[0], a[1]); r.y = cvtpk(a[2], a[3]); r.z = cvtpk(b[0], b[1]); r.w = cvtpk(b[2], b[3]);
    return __builtin_bit_cast(bf16x8, r);
}
#define MFMA16(a, b, c) __builtin_amdgcn_mfma_f32_16x16x32_bf16((a), (b), (c), 0, 0, 0)

template <bool PASS_C>
__device__ __forceinline__ void hgrn_item(const Frame& F, int seg, int h, int layer_j, const bf16* P, bf16* YM, float* sloc, const float* sin_, float* dseg, const float* lb_logits, const float* out_gain) {
    const int tid = F.tid, lane = F.lane, w = F.wave, g = lane >> 4, r16 = lane & 15;
    const int tr = tid >> 4, cg = tid & 15;
    LAS unsigned char* const L = F.lds;
    float lbv[8], oml[8], gain[8];
#pragma unroll
    for (int i = 0; i < 8; ++i) {
        const int ch = h * 128 + 8 * cg + i;
        float lb = 0.f;
        if (layer_j == 1) { const float l0 = lb_logits[ch], l1 = lb_logits[512 + ch]; lb = 1.f / (1.f + __expf(l0 - l1)); }
        lbv[i] = lb; oml[i] = 1.f - lb; gain[i] = PASS_C ? out_gain[8 * cg + i] : 0.f;
    }
    f32x4 S[8];
    const size_t sbase = ((size_t)(seg * 4 + h) * 8 + w) * 8 * 256 + lane * 4;
#pragma unroll
    for (int kt = 0; kt < 8; ++kt) S[kt] = PASS_C ? *(const GAS f32x4*)(sin_ + sbase + kt * 256) : (f32x4){0.f, 0.f, 0.f, 0.f};
    float lsum[8];
#pragma unroll
    for (int i = 0; i < 8; ++i) lsum[i] = 0.f;
    const bf16* base = P + (size_t)(seg * 256 + tr) * HYB_IN + h * 128 + 8 * cg;
    v4u nq = {0u, 0u, 0u, 0u}, nz, nv, ng = {0u, 0u, 0u, 0u};
    nz = *(const GAS v4u*)(base + 1024); nv = *(const GAS v4u*)(base + 1536);
    if (PASS_C) { nq = *(const GAS v4u*)(base + 512); ng = *(const GAS v4u*)(base + 2048); }
    for (int c = 0; c < 8; ++c) {
        const v4u cq = nq, cz = nz, cv = nv, cgt = ng;
        if (c + 1 < 8) { const bf16* nb = base + (size_t)(c + 1) * 32 * HYB_IN;
            nz = *(const GAS v4u*)(nb + 1024); nv = *(const GAS v4u*)(nb + 1536);
            if (PASS_C) { nq = *(const GAS v4u*)(nb + 512); ng = *(const GAS v4u*)(nb + 2048); } }
        float z[8], kk[8], b[8];
        unpack8(cz, z);
#pragma unroll
        for (int i = 0; i < 8; ++i) {
            const float e = __expf(-z[i]), sz = __builtin_amdgcn_rcpf(1.f + e);
            kk[i] = oml[i] * e * sz;
            float x = __logf(lbv[i] + oml[i] * sz);
            float y = __shfl_up(x, 16); if (lane >= 16) x += y;
            y = __shfl_up(x, 32); if (lane >= 32) x += y;
            b[i] = x;
        }
        if (g == 3) { *(LAS f32x4*)(L + HG_WT + w * 512 + cg * 32) = (f32x4){b[0], b[1], b[2], b[3]}; *(LAS f32x4*)(L + HG_WT + w * 512 + cg * 32 + 16) = (f32x4){b[4], b[5], b[6], b[7]}; }
        __syncthreads();
        float blast[8];
        {
            f32x4 pre0 = {0.f, 0.f, 0.f, 0.f}, pre1 = pre0, tot0 = pre0, tot1 = pre0;
#pragma unroll
            for (int ww = 0; ww < 8; ++ww) { const f32x4 t0 = *(const LAS f32x4*)(L + HG_WT + ww * 512 + cg * 32), t1 = *(const LAS f32x4*)(L + HG_WT + ww * 512 + cg * 32 + 16);
                tot0 += t0; tot1 += t1; if (ww < w) { pre0 += t0; pre1 += t1; } }
#pragma unroll
            for (int i = 0; i < 4; ++i) { b[i] += pre0[i]; b[4 + i] += pre1[i]; blast[i] = tot0[i]; blast[4 + i] = tot1[i]; }
        }
        {
            float kd[8], qt[8], kh[8], q[8];
            if (PASS_C) unpack8(cq, q);
#pragma unroll
            for (int i = 0; i < 8; ++i) {
                kd[i] = kk[i] * __expf(blast[i] - b[i]);
                if (PASS_C) { const float bc = fmaxf(b[i], -80.f); qt[i] = silu_f(q[i]) * __expf(bc); kh[i] = kk[i] * __expf(-bc); }
                lsum[i] += blast[i];
            }
            if (PASS_C) {
                v4u o; o.x = cvtpk(qt[0], qt[1]); o.y = cvtpk(qt[2], qt[3]); o.z = cvtpk(qt[4], qt[5]); o.w = cvtpk(qt[6], qt[7]);
                *(LAS v4u*)(L + HG_QT + tr * HG_RS + cg * 16) = o;
                o.x = cvtpk(kh[0], kh[1]); o.y = cvtpk(kh[2], kh[3]); o.z = cvtpk(kh[4], kh[5]); o.w = cvtpk(kh[6], kh[7]);
                *(LAS v4u*)(L + HG_KH + tr * HG_RS + cg * 16) = o;
            }
            const unsigned vw[4] = {cv.x, cv.y, cv.z, cv.w};
#pragma unroll
            for (int i = 0; i < 4; ++i) {
                const unsigned kp = cvtpk(kd[2 * i], kd[2 * i + 1]);
                *(LAS unsigned short*)(L + HG_KDT + (8 * cg + 2 * i) * HG_TS + tr * 2) = (unsigned short)(kp & 0xffffu);
                *(LAS unsigned short*)(L + HG_KDT + (8 * cg + 2 * i + 1) * HG_TS + tr * 2) = (unsigned short)(kp >> 16);
                *(LAS unsigned short*)(L + HG_VT + (8 * cg + 2 * i) * HG_TS + tr * 2) = (unsigned short)(vw[i] & 0xffffu);
                *(LAS unsigned short*)(L + HG_VT + (8 * cg + 2 * i + 1) * HG_TS + tr * 2) = (unsigned short)(vw[i] >> 16);
            }
            if (tr == 0) { *(LAS f32x4*)(L + HG_D + cg * 32) = (f32x4){__expf(blast[0]), __expf(blast[1]), __expf(blast[2]), __expf(blast[3])};
                           *(LAS f32x4*)(L + HG_D + cg * 32 + 16) = (f32x4){__expf(blast[4]), __expf(blast[5]), __expf(blast[6]), __expf(blast[7])}; }
        }
        __syncthreads();
        f32x4 o[2] = {{0.f, 0.f, 0.f, 0.f}, {0.f, 0.f, 0.f, 0.f}};
        if (PASS_C) {
            if (w == 3) { *(LAS unsigned long long*)(L + HG_AM + r16 * HG_TS + (16 + 4 * g) * 2) = 0ull; }
            else if (w < 3) {
                const int st = (w == 2) ? 1 : 0, tt = (w >= 1) ? 1 : 0;
                f32x4 acc = {0.f, 0.f, 0.f, 0.f};
#pragma unroll
                for (int ks = 0; ks < 4; ++ks) {
                    const bf16x8 a = *(const LAS bf16x8*)(L + HG_KH + (16 * st + r16) * HG_RS + (32 * ks + 8 * g) * 2);
                    const bf16x8 bq = *(const LAS bf16x8*)(L + HG_QT + (16 * tt + r16) * HG_RS + (32 * ks + 8 * g) * 2);
                    acc = MFMA16(a, bq, acc);
                }
                const int t = 16 * tt + r16, s0 = 16 * st + 4 * g;
#pragma unroll
                for (int r = 0; r < 4; ++r) acc[r] = (s0 + r <= t) ? acc[r] : 0.f;
                *(LAS unsigned long long*)(L + HG_AM + t * HG_TS + s0 * 2) = (unsigned long long)cvtpk(acc[0], acc[1]) | ((unsigned long long)cvtpk(acc[2], acc[3]) << 32);
            }
#pragma unroll
            for (int ks = 0; ks < 4; ++ks) {
                const bf16x8 bs = pack8(S[2 * ks], S[2 * ks + 1]);
#pragma unroll
                for (int mt = 0; mt < 2; ++mt) {
                    const unsigned long long a0 = *(const LAS unsigned long long*)(L + HG_QT + (16 * mt + r16) * HG_RS + (32 * ks + 4 * g) * 2);
                    const unsigned long long a1 = *(const LAS unsigned long long*)(L + HG_QT + (16 * mt + r16) * HG_RS + (32 * ks + 16 + 4 * g) * 2);
                    v4u av; av.x = (unsigned)a0; av.y = (unsigned)(a0 >> 32); av.z = (unsigned)a1; av.w = (unsigned)(a1 >> 32);
                    o[mt] = MFMA16(__builtin_bit_cast(bf16x8, av), bs, o[mt]);
                }
            }
            __syncthreads();
        }
        {
            const bf16x8 bv = *(const LAS bf16x8*)(L + HG_VT + (16 * w + r16) * HG_TS + 16 * g);
            if (PASS_C) {
#pragma unroll
                for (int mt = 0; mt < 2; ++mt) { const bf16x8 a = *(const LAS bf16x8*)(L + HG_AM + (16 * mt + r16) * HG_TS + 16 * g); o[mt] = MFMA16(a, bv, o[mt]); }
            }
#pragma unroll
            for (int kt = 0; kt < 8; ++kt) {
                const f32x4 dv = *(const LAS f32x4*)(L + HG_D + (16 * kt + 4 * g) * 4);
                const bf16x8 a = *(const LAS bf16x8*)(L + HG_KDT + (16 * kt + r16) * HG_TS + 16 * g);
                S[kt] = MFMA16(a, bv, S[kt] * dv);
            }
            if (PASS_C) {
#pragma unroll
                for (int mt = 0; mt < 2; ++mt)
#pragma unroll
                    for (int r = 0; r < 4; ++r) *(LAS float*)(L + HG_O + (16 * mt + 4 * g + r) * HG_OS + (16 * w + r16) * 4) = o[mt][r];
            }
        }
        __syncthreads();
        if (PASS_C) {
            const f32x4 o0 = *(const LAS f32x4*)(L + HG_O + tr * HG_OS + cg * 32), o1 = *(const LAS f32x4*)(L + HG_O + tr * HG_OS + cg * 32 + 16);
            float ss = (o0[0] * o0[0] + o0[1] * o0[1]) + (o0[2] * o0[2] + o0[3] * o0[3]) + (o1[0] * o1[0] + o1[1] * o1[1]) + (o1[2] * o1[2] + o1[3] * o1[3]);
            ss += __shfl_xor(ss, 1); ss += __shfl_xor(ss, 2); ss += __shfl_xor(ss, 4); ss += __shfl_xor(ss, 8);
            const float rstd = rsqrtf(ss * (1.f / 128.f) + EPS);
            float gt[8]; unpack8(cgt, gt);
            v4u y;
            y.x = cvtpk(o0[0] * rstd * gain[0] * silu_f(gt[0]), o0[1] * rstd * gain[1] * silu_f(gt[1]));
            y.y = cvtpk(o0[2] * rstd * gain[2] * silu_f(gt[2]), o0[3] * rstd * gain[3] * silu_f(gt[3]));
            y.z = cvtpk(o1[0] * rstd * gain[4] * silu_f(gt[4]), o1[1] * rstd * gain[5] * silu_f(gt[5]));
            y.w = cvtpk(o1[2] * rstd * gain[6] * silu_f(gt[6]), o1[3] * rstd * gain[7] * silu_f(gt[7]));
            *(GAS v4u*)(YM + (size_t)(seg * 256 + c * 32 + tr) * D + 512 + h * 128 + 8 * cg) = y;
        }
    }
    if (!PASS_C) {
#pragma unroll
        for (int kt = 0; kt < 8; ++kt) *(GAS f32x4*)(sloc + sbase + kt * 256) = S[kt];
        if (tr == 0) {
#pragma unroll
            for (int i = 0; i < 8; ++i) dseg[(seg * 4 + h) * 128 + 8 * cg + i] = __expf(lsum[i]);
        }
    }
    __syncthreads();
}
__device__ __forceinline__ void hgrn_pass_b(const Frame& F, int wg, int nwg, const float* sloc, float* sin_, const float* dseg) {
    for (int e = wg * (NWAVES * 64) + F.tid; e < 65536; e += nwg * (NWAVES * 64)) {
        const int h = e >> 14, rem = e & 16383, kt = (rem >> 8) & 7, ln = (rem >> 2) & 63, reg = rem & 3, k = 16 * kt + 4 * (ln >> 4) + reg;
        float cur = 0.f;
        for (int s0 = 0; s0 < 64; s0 += 8) {
            float dl[8], sl[8];
#pragma unroll
            for (int u = 0; u < 8; ++u) { dl[u] = dseg[((s0 + u) * 4 + h) * 128 + k]; sl[u] = sloc[(size_t)((s0 + u) * 4 + h) * 16384 + rem]; }
#pragma unroll
            for (int u = 0; u < 8; ++u) { sin_[(size_t)((s0 + u) * 4 + h) * 16384 + rem] = cur; cur = dl[u] * cur + sl[u]; }
        }
    }
}
__device__ __forceinline__ void pool_item(const Frame& F, int seg, int g, const bf16* P, bf16* YM) {
    const int cg = F.tid & 15, run = F.tid >> 4, t0 = seg * 256 + 8 * run, win = 2 << g;
    const bf16* up = P + g * 128 + 8 * cg;
    float sum[8];
#pragma unroll
    for (int i = 0; i < 8; ++i) sum[i] = 0.f;
    for (int r = t0 - (win - 1); r < t0; ++r) if (r >= 0) { float u[8]; unpack8(*(const GAS v4u*)(up + (size_t)r * HYB_IN), u);
#pragma unroll
        for (int i = 0; i < 8; ++i) sum[i] += u[i]; }
#pragma unroll
    for (int j = 0; j < 8; ++j) {
        const int t = t0 + j; float u[8]; unpack8(*(const GAS v4u*)(up + (size_t)t * HYB_IN), u);
        const float inv = 1.f / (float)((t + 1 < win) ? t + 1 : win);
        float dv[8];
#pragma unroll
        for (int i = 0; i < 8; ++i) { sum[i] += u[i]; dv[i] = sum[i] * inv - u[i]; }
        v4u o; o.x = cvtpk(dv[0], dv[1]); o.y = cvtpk(dv[2], dv[3]); o.z = cvtpk(dv[4], dv[5]); o.w = cvtpk(dv[6], dv[7]);
        *(GAS v4u*)(YM + (size_t)t * D + g * 128 + 8 * cg) = o;
        if (t - win + 1 >= 0) { float uo[8]; unpack8(*(const GAS v4u*)(up + (size_t)(t - win + 1) * HYB_IN), uo);
#pragma unroll
            for (int i = 0; i < 8; ++i) sum[i] -= uo[i]; }
    }
}
__device__ __forceinline__ void p0_weff_item(const float* pool_w_j, const float* scale_j, const float* wout_j, bf16* WT_j, LAS float* scr, int g, int nb, int lane) {
    const int n0 = 32 * nb;
#pragma unroll 8
    for (int i = 0; i < 64; ++i) { const int d = 2 * i + (lane >> 5); scr[d * 32 + (lane & 31)] = scale_j[g * 128 + d] * wout_j[(size_t)(g * 128 + d) * 1024 + n0 + (lane & 31)]; }
    LDS_WAIT(); asm volatile("" ::: "memory");
    for (int half = 0; half < 2; ++half) {
        const int c = lane + 64 * half;
        const float* pw = pool_w_j + (size_t)(g * 128 + c) * 128;
        float acc[32];
#pragma unroll
        for (int n = 0; n < 32; ++n) acc[n] = 0.f;
        for (int d4 = 0; d4 < 32; ++d4) {
            const f32x4 a = *(const GAS f32x4*)(pw + 4 * d4);
#pragma unroll
            for (int dd = 0; dd < 4; ++dd)
#pragma unroll
                for (int n = 0; n < 32; ++n) acc[n] += a[dd] * scr[(4 * d4 + dd) * 32 + n];
        }
#pragma unroll
        for (int n = 0; n < 32; ++n) WT_j[(size_t)(n0 + n) * 1024 + g * 128 + c] = (bf16)(cvtpk(acc[n], 0.f) & 0xffffu);
    }
    LDS_WAIT(); asm volatile("" ::: "memory");
}
typedef short v4i16_t __attribute__((ext_vector_type(4)));
constexpr int AT_V = 0, AT_VW = 9216  , AT_OST = 8 * AT_VW, AT_ML = AT_OST + 65536, AT_BIAS = AT_ML + 2048, AT_END = AT_BIAS + 3 * 132 * 4;
static_assert(AT_END <= MISC_OFF, "attention LDS map");
constexpr float AT_L2E = 1.4426950408889634f;
__device__ __forceinline__ int at_swz(int t) { return (t & 0xF0) | ((t ^ (t >> 4)) & 15); }
__device__ __forceinline__ void attn_task(const Frame& F, const bf16* QKV, bf16* YM, int hh, int T0, int grp, int tau) {
    const int lane = F.lane, g = lane >> 4, r16 = lane & 15;
    LAS unsigned char* const L = F.lds;
    LAS unsigned char* const Vb = L + AT_V + F.wave * AT_VW;
    const int dil = grp == 0 ? 1 : (grp == 1 ? 4 : 16);
    int r, tile;
    if (grp == 0) { r = 0; tile = tau; } else if (grp == 1) { r = tau & 3; tile = tau >> 2; } else { r = tau; tile = 0; }
    const int m0 = T0 / dil + 16 * tile;
    const int colq = grp * 512 + hh * 64, colk = 1536 + colq, colv = 3072 + colq;
    const int tq = (m0 + r16) * dil + r;
    bf16x8 qf[2];
#pragma unroll
    for (int ks = 0; ks < 2; ++ks) qf[ks] = *(const GAS bf16x8*)(QKV + (size_t)tq * ATT_QKV + colq + 32 * ks + 8 * g);
    f32x4 acc[9];
#pragma unroll
    for (int kt = 0; kt < 9; ++kt) {
        int mk = m0 - 128 + 16 * kt + r16; mk = mk < 0 ? 0 : mk;
        const bf16* kp = QKV + (size_t)(mk * dil + r) * ATT_QKV + colk + 8 * g;
        const bf16x8 k0 = *(const GAS bf16x8*)(kp), k1 = *(const GAS bf16x8*)(kp + 32);
        f32x4 a = {0.f, 0.f, 0.f, 0.f};
        a = MFMA16(k0, qf[0], a); a = MFMA16(k1, qf[1], a);
        acc[kt] = a;
    }
    const LAS float* bt = (const LAS float*)(L + AT_BIAS) + grp * 132;
    float mx = -INFINITY;
#pragma unroll
    for (int kt = 0; kt < 9; ++kt)
#pragma unroll
        for (int rr = 0; rr < 4; ++rr) {
            const int kw = 16 * kt + 4 * g + rr, dist = 128 + r16 - kw;
            const bool ok = (dist >= 0) && (dist <= 128) && (m0 - 128 + kw >= 0);
            const float s = ok ? acc[kt][rr] * (0.125f * AT_L2E) + bt[ok ? dist : 0] : -INFINITY;
            acc[kt][rr] = s; mx = fmaxf(mx, s);
        }
    mx = fmaxf(mx, __shfl_xor(mx, 16)); mx = fmaxf(mx, __shfl_xor(mx, 32));
    float lsum = 0.f;
#pragma unroll
    for (int kt = 0; kt < 9; ++kt)
#pragma unroll
        for (int rr = 0; rr < 4; ++rr) { const float p = __builtin_amdgcn_exp2f(acc[kt][rr] - mx); acc[kt][rr] = p; lsum += p; }
    lsum += __shfl_xor(lsum, 16); lsum += __shfl_xor(lsum, 32);
    f32x4 o[4];
#pragma unroll
    for (int dt = 0; dt < 4; ++dt) o[dt] = (f32x4){0.f, 0.f, 0.f, 0.f};
    const f32x4 zero4 = {0.f, 0.f, 0.f, 0.f};
#pragma unroll
    for (int ch = 0; ch < 3; ++ch) {
        v4u vr[8];
#pragma unroll
        for (int i = 0; i < 8; ++i) {
            int mk = m0 - 128 + 64 * ch + (lane >> 3) + 8 * i; mk = mk < 0 ? 0 : mk;
            int tk = mk * dil + r; tk = tk > M - 1 ? M - 1 : tk;
            vr[i] = *(const GAS v4u*)(QKV + (size_t)tk * ATT_QKV + colv + 8 * (lane & 7));
        }
        asm volatile("s_waitcnt lgkmcnt(0)" ::: "memory");
#pragma unroll
        for (int i = 0; i < 8; ++i) *(LAS v4u*)(Vb + ((lane >> 3) + 8 * i) * 144 + (lane & 7) * 16) = vr[i];
        asm volatile("s_waitcnt lgkmcnt(0)" ::: "memory");
#pragma unroll
        for (int kp = 0; kp < 2; ++kp) {
            const int kt0 = 4 * ch + 2 * kp, kt1 = kt0 + 1;
            if (kt0 > 8) continue;
            const bf16x8 pb = pack8(acc[kt0 > 8 ? 8 : kt0], kt1 > 8 ? zero4 : acc[kt1 > 8 ? 8 : kt1]);
#pragma unroll
            for (int dt = 0; dt < 4; ++dt) {
                const LAS unsigned char* a0 = Vb + (32 * kp + 4 * g + (r16 >> 2)) * 144 + (16 * dt + 4 * (r16 & 3)) * 2;
                const v4i16_t v0 = __builtin_amdgcn_ds_read_tr16_b64_v4i16((LAS v4i16_t*)a0);
                const v4i16_t v1 = __builtin_amdgcn_ds_read_tr16_b64_v4i16((LAS v4i16_t*)(a0 + 16 * 144));
                bf16x8 av; av[0] = v0[0]; av[1] = v0[1]; av[2] = v0[2]; av[3] = v0[3]; av[4] = v1[0]; av[5] = v1[1]; av[6] = v1[2]; av[7] = v1[3];
                o[dt] = MFMA16(av, pb, o[dt]);
            }
        }
    }
    const int tloc = tq - T0, tsw = at_swz(tloc);
    LAS f32x2* mlp = (LAS f32x2*)(L + AT_ML) + tloc;
    float m_run = mx, l_run = lsum;
    if (grp > 0) {
        const f32x2 ml = *mlp;
        const float mn = fmaxf(ml.x, mx), a = __builtin_amdgcn_exp2f(ml.x - mn), bnew = __builtin_amdgcn_exp2f(mx - mn);
#pragma unroll
        for (int dt = 0; dt < 4; ++dt) { const f32x4 oo = *(const LAS f32x4*)(L + AT_OST + ((4 * dt + g) * 256 + tsw) * 16); o[dt] = oo * a + o[dt] * bnew; }
        m_run = mn; l_run = ml.y * a + lsum * bnew;
    }
    if (grp < 2) {
#pragma unroll
        for (int dt = 0; dt < 4; ++dt) *(LAS f32x4*)(L + AT_OST + ((4 * dt + g) * 256 + tsw) * 16) = o[dt];
        if (g == 0) *mlp = (f32x2){m_run, l_run};
    } else {
        const float inv = 1.f / l_run;
#pragma unroll
        for (int dt = 0; dt < 4; ++dt) {
            const unsigned long long w = (unsigned long long)cvtpk(o[dt][0] * inv, o[dt][1] * inv) | ((unsigned long long)cvtpk(o[dt][2] * inv, o[dt][3] * inv) << 32);
            *(GAS unsigned long long*)(YM + (size_t)tq * 512 + hh * 64 + 16 * dt + 4 * g) = w;
        }
    }
}
__device__ __forceinline__ void attn_phase(const Frame& F, int bx, int G, const bf16* QKV, bf16* YM, const float* biastab) {
    LAS unsigned char* const L = F.lds;
    for (int it = F.vcu; it < 512; it += G) {
        const int hh = it >> 6, T0 = (it & 63) * 256;
        for (int i = F.tid; i < 3 * 129; i += NWAVES * 64) { const int grp = i / 129, jj = i % 129; ((LAS float*)(L + AT_BIAS))[grp * 132 + jj] = biastab[(grp * 8 + hh) * 129 + jj] * AT_L2E; }
        __syncthreads();
        for (int grp = 0; grp < 3; ++grp) {
            attn_task(F, QKV, YM, hh, T0, grp, F.wave);
            attn_task(F, QKV, YM, hh, T0, grp, F.wave + 8);
            __syncthreads();
        }
    }
}
__device__ __forceinline__ void p0a(Frame& F, const In& I, unsigned char* ws) {
    LAS float* scr = (LAS float*)(F.lds + F.wave * 16384);
    const int gw = F.vcu * NWAVES + F.wave, NGW = F.G * NWAVES;
    constexpr int I_FI = 16 * 176, I_FO = 44 * 32, I_HI = 16 * 80, I_HO = 8 * 32  , I_WE = 4 * 32, I_QKV = 16 * 144, I_AO = 8 * 32;
    constexpr int NT = 4 * I_FI + 4 * I_FO + 2 * (I_HI + I_HO + I_WE + I_QKV + I_AO), NMODP = 8 * 12 * 16;
    for (int it = gw; it < NT + NMODP; it += NGW) {
        int r = it;
        if (r < 4 * I_FI) { const int l = r / I_FI; p0_transpose_item(I.ffn_w_in + (size_t)l * 1024 * 5632, 1024, 5632, (bf16*)(ws + WS_WFI) + (size_t)l * 5632 * 1024, 1, scr, r % I_FI, F.lane); continue; } r -= 4 * I_FI;
        if (r < 4 * I_FO) { const int l = r / I_FO; p0_transpose_item(I.ffn_w_out + (size_t)l * 2816 * 1024, 2816, 1024, (bf16*)(ws + WS_WFO) + (size_t)l * 1024 * 2816, 0, scr, r % I_FO, F.lane); continue; } r -= 4 * I_FO;
        if (r < 2 * I_HI) { const int l = r / I_HI; p0_transpose_item(I.hyb_w_in + (size_t)l * 1024 * 2560, 1024, 2560, (bf16*)(ws + WS_WHI) + (size_t)l * 2560 * 1024, 0, scr, r % I_HI, F.lane); continue; } r -= 2 * I_HI;
        if (r < 2 * I_HO) { const int l = r / I_HO; p0_transpose_item(I.hyb_w_out + (size_t)l * 1024 * 1024, 1024, 1024, (bf16*)(ws + WS_WHO) + (size_t)l * 1024 * 1024, 0, scr, (r % I_HO) + 8 * 32, F.lane); continue; } r -= 2 * I_HO;
        if (r < 2 * I_WE) { const int l = r / I_WE, q = r % I_WE; p0_weff_item(I.pool_w + (size_t)l * 4 * 16384, I.pool_scale + l * 512, I.hyb_w_out + (size_t)l * 1024 * 1024, (bf16*)(ws + WS_WHO) + (size_t)l * 1024 * 1024, scr, q >> 5, q & 31, F.lane); continue; } r -= 2 * I_WE;
        if (r < 2 * I_QKV) { const int l = r / I_QKV; p0_transpose_item(I.att_w_qkv + (size_t)l * 1024 * 4608, 1024, 4608, (bf16*)(ws + WS_WQKV) + (size_t)l * 4608 * 1024, 0, scr, r % I_QKV, F.lane); continue; } r -= 2 * I_QKV;
        if (r < 2 * I_AO) { const int l = r / I_AO; p0_transpose_item(I.att_w_out + (size_t)l * 512 * 1024, 512, 1024, (bf16*)(ws + WS_WAO) + (size_t)l * 1024 * 512, 0, scr, r % I_AO, F.lane); continue; } r -= 2 * I_AO;
        {
            const int ls = r / 192, rem = r % 192, cb = rem / 16, kc = rem % 16;
            const float* w = I.ada_w + (size_t)ls * 1024 * 3072 + (size_t)(kc * 64) * 3072 + cb * 256 + F.lane * 4;
            f32x4 acc = {0.f, 0.f, 0.f, 0.f};
#pragma unroll 8
            for (int k = 0; k < 64; ++k) { const float s = silu_f(I.c[kc * 64 + k]); const f32x4 wv = *(const GAS f32x4*)(w + (size_t)k * 3072); acc += wv * s; }
            *(GAS f32x4*)((float*)(ws + WS_MODP) + (size_t)kc * 24576 + ls * 3072 + cb * 256 + F.lane * 4) = acc;
        }
    }
    for (int idx = blockIdx.x * (NWAVES * 64) + F.tid; idx < 24 * 129; idx += F.G * NWAVES * 64) {
        const int head = idx / 129, j = idx % 129, g = head >> 3, dil = g == 0 ? 1 : (g == 1 ? 4 : 16);
        ((float*)(ws + WS_BIAS))[idx] = I.rel_bias[t5_bucket(j * dil) * 24 + head];
    }
}
__device__ __forceinline__ float modp_sum(const float* modp, const float* ada_b, int idx) {
    float s = 0.f;
#pragma unroll
    for (int kc = 0; kc < 16; ++kc) s += modp[(size_t)kc * 24576 + idx];
    return s + ada_b[idx];
}
__device__ __forceinline__ void h_row_store(const f32x4 (&xv)[4], int lane, bf16* hrow, const float* g_pre, const float* shift, const float* scale) {
    float s = 0.f;
#pragma unroll
    for (int j = 0; j < 4; ++j) s += (xv[j].x * xv[j].x + xv[j].y * xv[j].y) + (xv[j].z * xv[j].z + xv[j].w * xv[j].w);
    const float rstd = rsqrtf(wave_sum(s) * (1.f / D) + EPS);
    GAS unsigned long long* o8 = (GAS unsigned long long*)hrow + lane;
#pragma unroll
    for (int j = 0; j < 4; ++j) {
        const f32x4 gp = ((const f32x4*)g_pre)[lane + 64 * j], sh = ((const f32x4*)shift)[lane + 64 * j], sc = ((const f32x4*)scale)[lane + 64 * j];
        const f32x4 hv = xv[j] * rstd * gp * (sc + 1.f) + sh;
        o8[64 * j] = (unsigned long long)pk2(hv.x, hv.y) | ((unsigned long long)pk2(hv.z, hv.w) << 32);
    }
}
__device__ __forceinline__ void p0b(Frame& F, const In& I, unsigned char* ws) {
    const float* modp = (const float*)(ws + WS_MODP);
    LAS float* ml = (LAS float*)F.lds;
    for (int i = F.tid; i < 2048; i += NWAVES * 64) ml[i] = modp_sum(modp, I.ada_b, i);
    for (int idx = blockIdx.x * (NWAVES * 64) + F.tid; idx < 24576; idx += F.G * NWAVES * 64) ((float*)(ws + WS_MOD))[idx] = modp_sum(modp, I.ada_b, idx);
    __syncthreads();
    const int gw = F.vcu * NWAVES + F.wave, NGW = F.G * NWAVES;
    for (int m = gw; m < M; m += NGW) {
        const GAS f32x4* xr = (const GAS f32x4*)(I.x + (size_t)m * D) + F.lane;
        f32x4 xv[4]; float s = 0.f;
#pragma unroll
        for (int j = 0; j < 4; ++j) { xv[j] = xr[64 * j]; s += (xv[j].x * xv[j].x + xv[j].y * xv[j].y) + (xv[j].z * xv[j].z + xv[j].w * xv[j].w); }
        const float rstd = rsqrtf(wave_sum(s) * (1.f / D) + EPS);
        GAS unsigned long long* o8 = (GAS unsigned long long*)((bf16*)(ws + WS_H) + (size_t)m * D) + F.lane;
#pragma unroll
        for (int j = 0; j < 4; ++j) {
            const f32x4 gp = ((const f32x4*)I.norm_pre)[F.lane + 64 * j];
            const f32x4 sh = *(const LAS f32x4*)(ml + 4 * (F.lane + 64 * j)), sc = *(const LAS f32x4*)(ml + 1024 + 4 * (F.lane + 64 * j));
            const f32x4 hv = xv[j] * rstd * gp * (sc + 1.f) + sh;
            o8[64 * j] = (unsigned long long)pk2(hv.x, hv.y) | ((unsigned long long)pk2(hv.z, hv.w) << 32);
        }
    }
    __syncthreads();
}
__device__ __forceinline__ void row_phase(Frame& F, const float* xin, const float* Y, float* out, bf16* H, const float* gate, const float* g_post, const float* g_pre, const float* shift, const float* scale) {
    const int gw = F.vcu * NWAVES + F.wave, NGW = F.G * NWAVES;
    for (int m = gw; m < M; m += NGW) {
        const GAS f32x4* xr = (const GAS f32x4*)(xin + (size_t)m * D) + F.lane;
        const GAS f32x4* yr = (const GAS f32x4*)(Y + (size_t)m * D) + F.lane;
        f32x4 xv[4], yv[4]; float s = 0.f;
#pragma unroll
        for (int j = 0; j < 4; ++j) { xv[j] = xr[64 * j]; yv[j] = yr[64 * j]; s += (yv[j].x * yv[j].x + yv[j].y * yv[j].y) + (yv[j].z * yv[j].z + yv[j].w * yv[j].w); }
        const float rstd = rsqrtf(wave_sum(s) * (1.f / D) + EPS);
        GAS f32x4* xo = (GAS f32x4*)(out + (size_t)m * D) + F.lane;
#pragma unroll
        for (int j = 0; j < 4; ++j) {
            const f32x4 ga = ((const f32x4*)gate)[F.lane + 64 * j], gp = ((const f32x4*)g_post)[F.lane + 64 * j];
            xv[j] = xv[j] + ga * (yv[j] * rstd * gp);
            xo[64 * j] = xv[j];
        }
        if (g_pre) h_row_store(xv, F.lane, H + (size_t)m * D, g_pre, shift, scale);
    }
}
namespace simple {
__device__ __forceinline__ bf16 f2bf(float f) { unsigned u = __float_as_uint(f); u += 0x7fffu + ((u >> 16) & 1u); return (bf16)(u >> 16); }
__device__ __forceinline__ float siluf(float v) { return v / (1.f + __expf(-v)); }
__device__ __forceinline__ float sigmf(float v) { return 1.f / (1.f + __expf(-v)); }
__global__ void k_pool(const bf16* P, const float* pool_w, const float* pool_scale, bf16* YM) {
    __shared__ float dv[16][128];
    const int g = blockIdx.y, t0 = blockIdx.x * 16, d = threadIdx.x;
    const int win = 2 << g;
    for (int tt = 0; tt < 16; ++tt) {
        const int t = t0 + tt; float s = 0.f; int cnt = 0;
        for (int i = 0; i < win; ++i) if (t - i >= 0) { s += bf2f(P[(size_t)(t - i) * HYB_IN + g * 128 + d]); ++cnt; }
        dv[tt][d] = s / (float)cnt - bf2f(P[(size_t)t * HYB_IN + g * 128 + d]);
    }
    __syncthreads();
    float acc[16];
#pragma unroll
    for (int tt = 0; tt < 16; ++tt) acc[tt] = 0.f;
    const float* w = pool_w + (size_t)g * 16384;
    for (int c = 0; c < 128; ++c) { const float wv = w[c * 128 + d];
#pragma unroll
        for (int tt = 0; tt < 16; ++tt) acc[tt] += dv[tt][c] * wv; }
    const float sc = pool_scale[g * 128 + d];
    for (int tt = 0; tt < 16; ++tt) YM[(size_t)(t0 + tt) * D + g * 128 + d] = f2bf(acc[tt] * sc);
}

__global__ void __launch_bounds__(128) k_hgrn(const bf16* P, const float* lb_logits, int layer_j, float* Oraw) {
    __shared__ float red[2][8];
    const int h = blockIdx.x, vb = blockIdx.y * 8, k = threadIdx.x, ch = h * 128 + k;
    float lb = 0.f;
    if (layer_j == 1) { const float l0 = lb_logits[ch], l1 = lb_logits[512 + ch]; lb = 1.f / (1.f + __expf(l0 - l1)); }
    float S[8];
#pragma unroll
    for (int j = 0; j < 8; ++j) S[j] = 0.f;
    for (int t = 0; t < M; ++t) {
        const bf16* pr = P + (size_t)t * HYB_IN;
        const float q = siluf(bf2f(pr[512 + ch])), z = bf2f(pr[1024 + ch]);
        const float kk = (1.f - lb) * sigmf(-z), f = 1.f - kk;
        float part[8];
#pragma unroll
        for (int j = 0; j < 8; ++j) { const float v = bf2f(pr[1536 + h * 128 + vb + j]); S[j] = f * S[j] + kk * v; part[j] = q * S[j]; }
#pragma unroll
        for (int j = 0; j < 8; ++j) part[j] = wave_sum(part[j]);
        if ((k & 63) == 0) {
#pragma unroll
            for (int j = 0; j < 8; ++j) red[k >> 6][j] = part[j];
        }
        __syncthreads();
        if (k < 8) Oraw[(size_t)t * 512 + h * 128 + vb + k] = red[0][k] + red[1][k];
        __syncthreads();
    }
}
__global__ void k_hgrn_out(const float* Oraw, const bf16* P, const float* out_gain, bf16* YM) {
    const int t = blockIdx.x * 4 + (threadIdx.x >> 6), lane = threadIdx.x & 63;
    for (int h = 0; h < 4; ++h) {
        const float o0 = Oraw[(size_t)t * 512 + h * 128 + lane], o1 = Oraw[(size_t)t * 512 + h * 128 + 64 + lane];
        const float rstd = rsqrtf(wave_sum(o0 * o0 + o1 * o1) * (1.f / 128.f) + EPS);
        const float g0 = bf2f(P[(size_t)t * HYB_IN + 2048 + h * 128 + lane]), g1 = bf2f(P[(size_t)t * HYB_IN + 2048 + h * 128 + 64 + lane]);
        YM[(size_t)t * D + 512 + h * 128 + lane] = f2bf(o0 * rstd * out_gain[lane] * siluf(g0));
        YM[(size_t)t * D + 512 + h * 128 + 64 + lane] = f2bf(o1 * rstd * out_gain[64 + lane] * siluf(g1));
    }
}

__global__ void k_attn(const bf16* QKV, const float* biastab, bf16* YM) {
    const int gid = blockIdx.x * blockDim.x + threadIdx.x;
    const int item = gid >> 2, sub = gid & 3;
    const int t = item >> 3, hh = item & 7;
    float o[16]; float mrun = -INFINITY, lrun = 0.f;
#pragma unroll
    for (int e = 0; e < 16; ++e) o[e] = 0.f;
    for (int g = 0; g < 3; ++g) {
        const int dil = g == 0 ? 1 : (g == 1 ? 4 : 16);
        float q[16];
        const bf16* qp = QKV + (size_t)t * ATT_QKV + g * 512 + hh * 64 + sub * 16;
#pragma unroll
        for (int e = 0; e < 16; ++e) q[e] = bf2f(qp[e]) * 0.125f;
        const float* bt = biastab + (g * 8 + hh) * 129;
        for (int j = 0; j <= 128; ++j) {
            const int tp = t - j * dil; if (tp < 0) break;
            const bf16* kp = QKV + (size_t)tp * ATT_QKV + 1536 + g * 512 + hh * 64 + sub * 16;
            const bf16* vp = kp + 1536;
            float s = 0.f;
#pragma unroll
            for (int e = 0; e < 16; ++e) s += q[e] * bf2f(kp[e]);
            s += __shfl_xor(s, 1); s += __shfl_xor(s, 2);
            s += bt[j];
            const float mn = fmaxf(mrun, s), al = __expf(mrun - mn), p = __expf(s - mn);
            lrun = lrun * al + p;
#pragma unroll
            for (int e = 0; e < 16; ++e) o[e] = o[e] * al + p * bf2f(vp[e]);
            mrun = mn;
        }
    }
    const float inv = 1.f / lrun;
    bf16* op = YM + (size_t)t * 512 + hh * 64 + sub * 16;
#pragma unroll
    for (int e = 0; e < 16; ++e) op[e] = f2bf(o[e] * inv);
}

}
constexpr int NPH = 2 + 9 * DEPTH;
struct Args { const float* in[17]; float* out; unsigned char* ws; int ph_lo, ph_hi, li, mixer_in_kernel; };
__device__ __forceinline__ bool phase_is_live(int ph, int mixer_in_kernel) {
    if (ph < 2) return true;
    const int l = (ph - 2) / 9, k = (ph - 2) % 9;
    if (k >= 1 && k <= 3) { if (l & 1) return (mixer_in_kernel & 2) && k == 1; return (mixer_in_kernel & 1) != 0; }
    return true;
}
__global__ void __launch_bounds__(NWAVES * 64, 2) trunk_fwd(Args args) {
    extern __shared__ __attribute__((aligned(16))) unsigned char lds[];
    {
        volatile LAS unsigned* misc = (volatile LAS unsigned*)((LAS unsigned char*)lds + MISC_OFF);
        if (threadIdx.x < 64) misc[threadIdx.x] = 0u;
        if (threadIdx.x < 17) ((volatile LAS unsigned long long*)((LAS unsigned char*)lds + PTR_OFF))[threadIdx.x] = (unsigned long long)args.in[threadIdx.x];
    }
    __syncthreads();
    XcdBarrier bar = xcd_barrier_post((unsigned*)((gu32*)(args.ws + WS_CTL) + CW_BAR) + args.li * XCD_BAR_WORDS, (volatile LAS unsigned*)((LAS unsigned char*)lds + MISC_OFF) + 8);
    bool did_any = false;
    for (int ph = args.ph_lo; ph < args.ph_hi; ++ph) {
        if (!phase_is_live(ph, args.mixer_in_kernel)) continue;
        if (did_any) xcd_barrier(bar);
        did_any = true;
        unsigned char* ws = args.ws; float* out = args.out; int G = (int)gridDim.x, bx = (int)blockIdx.x, tid0 = (int)threadIdx.x;
        asm volatile("" : "+s"(ws), "+s"(out), "+s"(G), "+s"(bx)); asm volatile("" : "+v"(tid0));
        Frame F;
        F.lds = (LAS unsigned char*)lds; F.MISC = (volatile LAS unsigned*)(F.lds + MISC_OFF); F.ctl = (gu32*)(ws + WS_CTL);
        F.tid = tid0; F.lane = tid0 & 63; F.wave = __builtin_amdgcn_readfirstlane(tid0 >> 6); F.G = G; F.vcu = (G % 8 == 0) ? (bx % 8) * (G / 8) + bx / 8 : bx;
        bf16* const H = (bf16*)(ws + WS_H); bf16* const P = (bf16*)(ws + WS_P); bf16* const YM = (bf16*)(ws + WS_YM); float* const Y = (float*)(ws + WS_Y);
        const float* const mod = (const float*)(ws + WS_MOD);
        if (ph == 0) { const In I = load_in(F); p0a(F, I, ws); continue; }
        if (ph == 1) { const In I = load_in(F); p0b(F, I, ws); continue; }
        const int l = (ph - 2) / 9, k = (ph - 2) % 9, j = l >> 1; const bool hyb = !(l & 1);
        if (k == 0) {
            const int N = hyb ? HYB_IN : ATT_QKV;
            const bf16* Bt = hyb ? (const bf16*)(ws + WS_WHI) + (size_t)j * 2560 * 1024 : (const bf16*)(ws + WS_WQKV) + (size_t)j * 4608 * 1024;
            pg8::Gemm g{H, Bt, M, N, 1024}; pg8::StaticOrder S; S.init(M, N, G, bx);
            pg8::EpiBf16 E{P, N};
            pg8::gemm_phase<pg8::EpiBf16, pg8::StaticOrder, PG8_ALIGN, PG8_SP2, 1024>(F.lds, g, S, E);
        } else if (k == 4 || k == 7) {
            const bf16* A = (k == 4) ? YM : P;
            const int K = (k == 4) ? (hyb ? 1024 : 512) : DFF;
            const bf16* Bt = (k == 4) ? (hyb ? (const bf16*)(ws + WS_WHO) + (size_t)j * 1024 * 1024 : (const bf16*)(ws + WS_WAO) + (size_t)j * 1024 * 512) : (const bf16*)(ws + WS_WFO) + (size_t)l * 1024 * 2816;
            pg8::Gemm g{A, Bt, M, D, K}; pg8::StaticOrder S; S.init(M, D, G, bx);
            pg8::EpiF32 E{Y, D};
            if (K == 1024) pg8::gemm_phase<pg8::EpiF32, pg8::StaticOrder, PG8_ALIGN, PG8_SP2, 1024>(F.lds, g, S, E);
            else if (K == 512) pg8::gemm_phase<pg8::EpiF32, pg8::StaticOrder, PG8_ALIGN, PG8_SP2, 512>(F.lds, g, S, E);
            else pg8::gemm_phase<pg8::EpiF32, pg8::StaticOrder, PG8_ALIGN, PG8_SP2, DFF>(F.lds, g, S, E);
        } else if (k == 6) {
            pg8::Gemm g{H, (const bf16*)(ws + WS_WFI) + (size_t)l * 5632 * 1024, M, 2 * DFF, 1024}; pg8::StaticOrder S; S.init(M, 2 * DFF, G, bx);
            pg8::EpiSwiglu E{P, DFF};
            pg8::gemm_phase<pg8::EpiSwiglu, pg8::StaticOrder, PG8_ALIGN, PG8_SP2, 1024>(F.lds, g, S, E);
        } else if (k >= 1 && k <= 3) {
            if (hyb) {
                float* sloc = (float*)(ws + WS_SLOC); float* sin_ = (float*)(ws + WS_SIN); float* dseg = (float*)(ws + WS_DSEG);
                if (k == 1) { const float* lbl = inptr(F, IN_LB_LOGITS);
                    for (int it = bx; it < 256; it += G) hgrn_item<false>(F, it >> 2, it & 3, j, P, YM, sloc, sin_, dseg, lbl, nullptr); }
                else if (k == 2) {
                    if (G >= 256) { if (bx < 128) hgrn_pass_b(F, bx, 128, sloc, sin_, dseg); else for (int it = bx - 128; it < 256; it += G - 128) pool_item(F, it >> 2, it & 3, P, YM); }
                    else { hgrn_pass_b(F, bx, G, sloc, sin_, dseg); for (int it = bx; it < 256; it += G) pool_item(F, it >> 2, it & 3, P, YM); }
                } else { const float* lbl = inptr(F, IN_LB_LOGITS); const float* og = inptr(F, IN_OUT_NORM) + j * 128;
                    for (int it = bx; it < 256; it += G) hgrn_item<true>(F, it >> 2, it & 3, j, P, YM, sloc, sin_, dseg, lbl, og); }
            } else attn_phase(F, bx, G, P, YM, (const float*)(ws + WS_BIAS));
        } else if (k == 5 || k == 8) {
            const int sl = (k == 5) ? 0 : 1;
            const int ln = (k == 5) ? l : l + 1, sn = (k == 5) ? 1 : 0;
            const float* mg = mod + (l * 2 + sl) * 3072;
            const float* norm_pre = inptr(F, IN_NORM_PRE); const float* norm_post = inptr(F, IN_NORM_POST);
            const float* xin = (l == 0 && k == 5) ? inptr(F, IN_X) : out;
            if (ln < DEPTH) { const float* mn = mod + (ln * 2 + sn) * 3072;
                row_phase(F, xin, Y, out, H, mg + 2048, norm_post + (l * 2 + sl) * D, norm_pre + (ln * 2 + sn) * D, mn, mn + 1024); }
            else row_phase(F, xin, Y, out, H, mg + 2048, norm_post + (l * 2 + sl) * D, nullptr, nullptr, nullptr);
        }
    }
}
#ifndef USE_COOP
#define USE_COOP 1
#endif
#ifndef MIXER_IN_KERNEL
#define MIXER_IN_KERNEL 3
#endif
static void launch_mega(int grid, Args& a, int lo, int hi, int li, hipStream_t stream) {
    a.ph_lo = lo; a.ph_hi = hi; a.li = li;
#if USE_COOP
    void* params[] = {&a};
    const hipError_t le = hipLaunchCooperativeKernel((const void*)trunk_fwd, dim3(grid), dim3(NWAVES * 64), params, LDS_BYTES, stream);
#else
    hipLaunchKernelGGL(trunk_fwd, dim3(grid), dim3(NWAVES * 64), LDS_BYTES, stream, a);
    const hipError_t le = hipPeekAtLastError();
#endif
    if (le != hipSuccess) fprintf(stderr, "kernel_launch: launch %d failed: %s (grid %d x %d threads, %d B LDS)\n", li, hipGetErrorName(le), grid, NWAVES * 64, LDS_BYTES);
}
extern "C" void kernel_launch(void* const* d_in, const int* in_sizes, int n_in, void* d_out, int out_size, void* d_ws, size_t ws_size, hipStream_t stream) {
    static int grid = 0;
    if (grid == 0) {
        if (n_in != 17 || in_sizes[0] != M * D || out_size != M * D || ws_size < WS_END) {
            fprintf(stderr, "kernel_launch: unexpected shapes: n_in %d in0 %d out %d ws %zu (need %zu); nothing launched\n", n_in, n_in > 0 ? in_sizes[0] : -1, out_size, ws_size, (size_t)WS_END); grid = -1; return; }
        int dev = 0, cus = 0, per_cu = 0;
        if (hipGetDevice(&dev) != hipSuccess || hipDeviceGetAttribute(&cus, hipDeviceAttributeMultiprocessorCount, dev) != hipSuccess) { fprintf(stderr, "kernel_launch: device query failed\n"); grid = -1; return; }
        if (hipFuncSetAttribute((const void*)trunk_fwd, hipFuncAttributeMaxDynamicSharedMemorySize, LDS_BYTES) != hipSuccess) { fprintf(stderr, "kernel_launch: hipFuncSetAttribute(%d B LDS) failed\n", LDS_BYTES); grid = -1; return; }
        if (hipOccupancyMaxActiveBlocksPerMultiprocessor(&per_cu, (const void*)trunk_fwd, NWAVES * 64, LDS_BYTES) != hipSuccess || per_cu < 1) {
            fprintf(stderr, "kernel_launch: occupancy query reports %d workgroups per CU\n", per_cu); (void)hipGetLastError(); per_cu = 1; }
        grid = cus;
        if (grid != 256) fprintf(stderr, "kernel_launch: note: %d CUs (built and tuned for 256)\n", grid);
    }
    if (grid < 0) return;
    if (hipMemsetAsync((char*)d_ws + WS_CTL, 0, CTL_ZERO_BYTES, stream) != hipSuccess) { fprintf(stderr, "kernel_launch: hipMemsetAsync failed\n"); return; }
    Args a{};
    for (int i = 0; i < 17; ++i) a.in[i] = (const float*)d_in[i];
    a.out = (float*)d_out; a.ws = (unsigned char*)d_ws; a.mixer_in_kernel = MIXER_IN_KERNEL;
    unsigned char* ws = (unsigned char*)d_ws;
    bf16* P = (bf16*)(ws + WS_P); bf16* YM = (bf16*)(ws + WS_YM); float* Oraw = (float*)(ws + WS_ORAW);
    int lo = 0, li = 0;
    for (int l = 0; l < DEPTH; ++l) {
        const int b = 2 + 9 * l, j = l / 2; const bool hyb = (l % 2 == 0);
        if ((MIXER_IN_KERNEL >> (hyb ? 0 : 1)) & 1) continue;
        launch_mega(grid, a, lo, b + 1, li++, stream);
        if (hyb) {
            simple::k_pool<<<dim3(M / 16, 4), 128, 0, stream>>>(P, (const float*)d_in[10] + (size_t)j * 4 * 16384, (const float*)d_in[11] + j * 512, YM);
            simple::k_hgrn<<<dim3(4, 16), 128, 0, stream>>>(P, (const float*)d_in[12], j, Oraw);
            simple::k_hgrn_out<<<M / 4, 256, 0, stream>>>(Oraw, P, (const float*)d_in[13] + j * 128, YM);
        } else {
            simple::k_attn<<<M * 8 * 4 / 256, 256, 0, stream>>>(P, (const float*)(ws + WS_BIAS), YM);
        }
        lo = b + 4;
    }
    launch_mega(grid, a, lo, NPH, li++, stream);
}
```
